# Optimizing an MI355X kernel written in HIP

```python
import jax, jax.numpy as jnp
from jax import lax
import numpy as np

D_MODEL = 2048
BATCH = 4
SEQ = 4096
DEPTH = 2

HEAD_DIM = 128
MLSTM_WIDTH = D_MODEL // 4
MLSTM_HEADS = MLSTM_WIDTH // HEAD_DIM
POOL_WIDTH = D_MODEL // 4
POOL_WINDOWS = (2, 4, 8, 16)
POOL_GROUPS = len(POOL_WINDOWS)
POOL_GROUP_DIM = POOL_WIDTH // POOL_GROUPS
FOX_WIDTH = D_MODEL - MLSTM_WIDTH - POOL_WIDTH
FOX_HEADS = FOX_WIDTH // HEAD_DIM
D_FF = ((8 * D_MODEL // 3 + 255) // 256) * 256
CONV_WIDTH = 4
MLSTM_CHUNK = 128
FOX_BLOCK = 128
RMS_EPS = 1e-6
FFN_RESIDUAL_WEIGHT = 0.5

OFF_MQ = 0
OFF_MK = OFF_MQ + MLSTM_WIDTH
OFF_MV = OFF_MK + MLSTM_WIDTH
OFF_MO = OFF_MV + MLSTM_WIDTH
OFF_MI = OFF_MO + MLSTM_WIDTH
OFF_MF = OFF_MI + MLSTM_HEADS
OFF_POOL = OFF_MF + MLSTM_HEADS
OFF_AQ = OFF_POOL + POOL_WIDTH
OFF_AK = OFF_AQ + FOX_WIDTH
OFF_AV = OFF_AK + FOX_WIDTH
OFF_AF = OFF_AV + FOX_WIDTH
N_IN = OFF_AF + FOX_HEADS

kernel_name = 'hybrid_mlstm_pool_fox_macaron'


def rms_norm(x, g):
    xf = x.astype(jnp.float32)
    y = xf * lax.rsqrt(jnp.mean(xf * xf, axis=-1, keepdims=True) + RMS_EPS)
    return (y * g.astype(jnp.float32)).astype(x.dtype)


def swiglu(h, w_gate, w_up, w_down):
    return (jax.nn.silu(h @ w_gate) * (h @ w_up)) @ w_down


def split_heads(t, n_heads):
    b, s, _ = t.shape
    return t.reshape(b, s, n_heads, HEAD_DIM).transpose(0, 2, 1, 3)


def merge_heads(t):
    b, h, s, d = t.shape
    return t.transpose(0, 2, 1, 3).reshape(b, s, h * d)


def causal_short_conv(u, w):
    s = u.shape[1]
    y = u * w[0]
    for j in range(1, CONV_WIDTH):
        y = y + jnp.pad(u, ((0, 0), (j, 0), (0, 0)))[:, :s] * w[j]
    return jax.nn.silu(y)


def mlstm_chunkwise(q, k, v, i_pre, log_f):
    b, nh, s, dh = q.shape
    nc = s // MLSTM_CHUNK
    L = MLSTM_CHUNK
    f32 = jnp.float32
    q = q.astype(f32) * (dh ** -0.5)
    to_chunks = lambda t: t.astype(f32).reshape(b, nh, nc, L, dh).transpose(2, 0, 1, 3, 4)
    to_chunks_g = lambda t: t.astype(f32).reshape(b, nh, nc, L).transpose(2, 0, 1, 3)
    xs = (to_chunks(q), to_chunks(k), to_chunks(v), to_chunks_g(i_pre), to_chunks_g(log_f))
    tri = jnp.tril(jnp.ones((L, L), dtype=bool))

    def step(carry, inp):
        C, n, m = carry
        qc, kc, vc, ic, fc = inp
        bcum = jnp.cumsum(fc, axis=-1)
        log_d = bcum[..., :, None] - bcum[..., None, :] + ic[..., None, :]
        log_d = jnp.where(tri, log_d, -jnp.inf)
        inter = bcum + m[..., None]
        m_t = jnp.maximum(inter, jnp.max(log_d, axis=-1))
        scores = jnp.einsum('bhtd,bhsd->bhts', qc, kc) * jnp.exp(log_d - m_t[..., None])
        inter_w = jnp.exp(inter - m_t)
        num = (jnp.einsum('bhts,bhsd->bhtd', scores, vc)
               + inter_w[..., None] * jnp.einsum('bhtk,bhkv->bhtv', qc, C))
        den = scores.sum(-1) + inter_w * jnp.einsum('bhtk,bhk->bht', qc, n)
        h = num / jnp.maximum(jnp.abs(den), jnp.exp(-m_t))[..., None]
        b_last = bcum[..., -1]
        log_w = b_last[..., None] - bcum + ic
        m_new = jnp.maximum(b_last + m, jnp.max(log_w, axis=-1))
        w = jnp.exp(log_w - m_new[..., None])
        decay = jnp.exp(b_last + m - m_new)
        C_new = decay[..., None, None] * C + jnp.einsum('bhs,bhsk,bhsv->bhkv', w, kc, vc)
        n_new = decay[..., None] * n + jnp.einsum('bhs,bhsk->bhk', w, kc)
        return (C_new, n_new, m_new), h

    init = (jnp.zeros((b, nh, dh, dh), f32), jnp.zeros((b, nh, dh), f32), jnp.zeros((b, nh), f32))
    _, hs = lax.scan(step, init, xs)
    return hs.transpose(1, 2, 0, 3, 4).reshape(b, nh, s, dh)


def multiscale_pool(u, pool_w, pool_scale):
    b, s, _ = u.shape
    uf = u.astype(jnp.float32)
    cs = jnp.cumsum(uf, axis=1)
    count = jnp.arange(1, s + 1, dtype=jnp.float32)
    diffs = []
    for g, win in enumerate(POOL_WINDOWS):
        sl = slice(g * POOL_GROUP_DIM, (g + 1) * POOL_GROUP_DIM)
        csg = cs[..., sl]
        prev = jnp.pad(csg, ((0, 0), (win, 0), (0, 0)))[:, :s]
        mean = (csg - prev) / jnp.minimum(count, float(win))[None, :, None]
        diffs.append(mean - uf[..., sl])
    d = jnp.stack(diffs, axis=2).astype(u.dtype)
    y = jnp.einsum('bsgc,gcd->bsgd', d, pool_w).reshape(b, s, POOL_WIDTH)
    return y * pool_scale


def forgetting_attention(q, k, v, log_f):
    b, nh, s, dh = q.shape
    nb = s // FOX_BLOCK
    c = jnp.cumsum(log_f, axis=-1)
    qb = q.reshape(b, nh, nb, FOX_BLOCK, dh).transpose(2, 0, 1, 3, 4)
    cb = c.reshape(b, nh, nb, FOX_BLOCK).transpose(2, 0, 1, 3)
    starts = jnp.arange(nb, dtype=jnp.int32) * FOX_BLOCK
    k_pos = jnp.arange(s, dtype=jnp.int32)
    scale = dh ** -0.5

    def block(args):
        q_blk, c_blk, start = args
        logits = (jnp.einsum('bhqd,bhkd->bhqk', q_blk, k).astype(jnp.float32) * scale
                  + c_blk[..., :, None] - c[..., None, :])
        q_pos = start + jnp.arange(FOX_BLOCK, dtype=jnp.int32)
        logits = jnp.where(k_pos[None, :] <= q_pos[:, None], logits, -jnp.inf)
        p = jax.nn.softmax(logits, axis=-1)
        return jnp.einsum('bhqk,bhkd->bhqd', p.astype(v.dtype), v)

    out = lax.map(block, (qb, cb, starts))
    return out.transpose(1, 2, 0, 3, 4).reshape(b, nh, s, dh)


def hybrid_mixer(h, w_in, mlstm_conv, mlstm_b_i, mlstm_b_f, mlstm_head_g,
                 pool_w, pool_scale, fox_b_f, w_out):
    p = h @ w_in
    qk = causal_short_conv(p[..., OFF_MQ:OFF_MV], mlstm_conv)
    mq, mk = qk[..., :MLSTM_WIDTH], qk[..., MLSTM_WIDTH:]
    mv = p[..., OFF_MV:OFF_MO]
    mo = p[..., OFF_MO:OFF_MI]
    mi = (p[..., OFF_MI:OFF_MF] + mlstm_b_i).astype(jnp.float32).transpose(0, 2, 1)
    mf = jax.nn.log_sigmoid((p[..., OFF_MF:OFF_POOL] + mlstm_b_f).astype(jnp.float32)).transpose(0, 2, 1)
    hm = mlstm_chunkwise(split_heads(mq, MLSTM_HEADS), split_heads(mk, MLSTM_HEADS),
                         split_heads(mv, MLSTM_HEADS), mi, mf)
    hm = hm * lax.rsqrt(jnp.mean(hm * hm, axis=-1, keepdims=True) + RMS_EPS)
    hm = merge_heads(hm).astype(h.dtype) * mlstm_head_g * jax.nn.sigmoid(mo)
    hp = multiscale_pool(p[..., OFF_POOL:OFF_AQ], pool_w, pool_scale)
    aq = split_heads(p[..., OFF_AQ:OFF_AK], FOX_HEADS)
    ak = split_heads(p[..., OFF_AK:OFF_AV], FOX_HEADS)
    av = split_heads(p[..., OFF_AV:OFF_AF], FOX_HEADS)
    af = jax.nn.log_sigmoid((p[..., OFF_AF:N_IN] + fox_b_f).astype(jnp.float32)).transpose(0, 2, 1)
    ha = merge_heads(forgetting_attention(aq, ak, av, af))
    return jnp.concatenate([hm, hp.astype(h.dtype), ha.astype(h.dtype)], axis=-1) @ w_out


def setup_inputs(seed: int = 0) -> dict:
    key = jax.random.key(seed)
    ks = jax.random.split(key, 24)
    f32 = jnp.float32

    def w(k, shape, fan_in):
        return jax.random.normal(k, shape, f32) * (fan_in ** -0.5)

    def gain(k, shape):
        return 1.0 + 0.05 * jax.random.normal(k, shape, f32)

    return {
        'x': jax.random.normal(ks[0], (BATCH, SEQ, D_MODEL), f32),
        'ffn1_pre_g': gain(ks[1], (DEPTH, D_MODEL)),
        'ffn1_post_g': gain(ks[2], (DEPTH, D_MODEL)),
        'ffn1_w_gate': w(ks[3], (DEPTH, D_MODEL, D_FF), D_MODEL),
        'ffn1_w_up': w(ks[4], (DEPTH, D_MODEL, D_FF), D_MODEL),
        'ffn1_w_down': w(ks[5], (DEPTH, D_FF, D_MODEL), D_FF),
        'mix_pre_g': gain(ks[6], (DEPTH, D_MODEL)),
        'mix_post_g': gain(ks[7], (DEPTH, D_MODEL)),
        'w_in': w(ks[8], (DEPTH, D_MODEL, N_IN), D_MODEL),
        'mlstm_conv': w(ks[9], (DEPTH, CONV_WIDTH, 2 * MLSTM_WIDTH), CONV_WIDTH),
        'mlstm_b_i': 0.1 * jax.random.normal(ks[10], (DEPTH, MLSTM_HEADS), f32),
        'mlstm_b_f': jax.random.uniform(ks[11], (DEPTH, MLSTM_HEADS), f32, 3.0, 6.0),
        'mlstm_head_g': gain(ks[12], (DEPTH, MLSTM_WIDTH)),
        'pool_w': w(ks[13], (DEPTH, POOL_GROUPS, POOL_GROUP_DIM, POOL_GROUP_DIM), POOL_GROUP_DIM),
        'pool_scale': gain(ks[14], (DEPTH, POOL_WIDTH)),
        'fox_b_f': jax.random.uniform(ks[15], (DEPTH, FOX_HEADS), f32, 1.0, 6.0),
        'w_out': w(ks[16], (DEPTH, D_MODEL, D_MODEL), D_MODEL),
        'ffn2_pre_g': gain(ks[17], (DEPTH, D_MODEL)),
        'ffn2_post_g': gain(ks[18], (DEPTH, D_MODEL)),
        'ffn2_w_gate': w(ks[19], (DEPTH, D_MODEL, D_FF), D_MODEL),
        'ffn2_w_up': w(ks[20], (DEPTH, D_MODEL, D_FF), D_MODEL),
        'ffn2_w_down': w(ks[21], (DEPTH, D_FF, D_MODEL), D_FF),
    }


def reference(x, ffn1_pre_g, ffn1_post_g, ffn1_w_gate, ffn1_w_up, ffn1_w_down,
              mix_pre_g, mix_post_g, w_in, mlstm_conv, mlstm_b_i, mlstm_b_f, mlstm_head_g,
              pool_w, pool_scale, fox_b_f, w_out,
              ffn2_pre_g, ffn2_post_g, ffn2_w_gate, ffn2_w_up, ffn2_w_down):
    for l in range(DEPTH):
        h = swiglu(rms_norm(x, ffn1_pre_g[l]), ffn1_w_gate[l], ffn1_w_up[l], ffn1_w_down[l])
        x = x + FFN_RESIDUAL_WEIGHT * rms_norm(h, ffn1_post_g[l])
        h = hybrid_mixer(rms_norm(x, mix_pre_g[l]), w_in[l], mlstm_conv[l], mlstm_b_i[l],
                         mlstm_b_f[l], mlstm_head_g[l], pool_w[l], pool_scale[l],
                         fox_b_f[l], w_out[l])
        x = x + rms_norm(h, mix_post_g[l])
        h = swiglu(rms_norm(x, ffn2_pre_g[l]), ffn2_w_gate[l], ffn2_w_up[l], ffn2_w_down[l])
        x = x + FFN_RESIDUAL_WEIGHT * rms_norm(h, ffn2_post_g[l])
    return x
```

```cpp
#include <hip/hip_runtime.h>
#include <hip/hip_cooperative_groups.h>
#include <cstdio>
#include <cstdint>
namespace cg = cooperative_groups;

#ifndef MK_COOP
#define MK_COOP 1
#endif

__device__ __forceinline__ int mytid() { int t = threadIdx.x; asm volatile("" : "+v"(t)); return t; }
namespace pg8 {
#define PG8_LAS __attribute__((address_space(3)))
typedef unsigned short bf16_t;
typedef short bf16x8 __attribute__((ext_vector_type(8)));
typedef float f32x4 __attribute__((ext_vector_type(4)));
typedef unsigned u32x4 __attribute__((ext_vector_type(4)));
constexpr int BM = 256, BK = 64, HALF = 128, HTB = HALF * BK * 2  , STAGE_BYTES = 8 * HTB, NXCD = 8, WGM = 8;

__host__ __device__ __forceinline__ int lds_byte(int r, int c) { const int st = (r >> 4) * 2 + (c >> 5), rr = r & 15, cc = c & 31, ob = rr * 64 + cc * 2; return st * 1024 + (ob ^ (((ob >> 9) & 1) << 5)); }
__host__ __device__ __forceinline__ void stage_rc(int b, int& R, int& C) { const int st = b / 1024, sb = b % 1024, swz = sb ^ (((sb >> 9) & 1) << 5); R = (st >> 1) * 16 + swz / 64; C = (st & 1) * 32 + (swz % 64) / 2; }
__host__ __device__ __forceinline__ int perm32(int rho) { const int n = rho >> 4, i = rho & 15; return 8 * (i >> 2) + 4 * n + (i & 3); }

struct Unit { int pm, pn, job; };
struct Gemm { const bf16_t* A; const bf16_t* Bt; int M, N, K; const bf16_t* A2; const bf16_t* Bt2; };

struct StaticOrder {
    int nM, nN, nwg, G, c;
    __host__ __device__ void init(int M, int N, int G_, int c_) { nM = M / BM; nN = N / BM; nwg = nM * nN; G = G_; c = c_; }
    __host__ __device__ void map(long L, Unit& u) const {
        int wgid = (int)L; { const int q = nwg / NXCD, r = nwg % NXCD, xcd = wgid % NXCD, off = wgid / NXCD; wgid = (xcd < r ? xcd * (q + 1) : r * (q + 1) + (xcd - r) * q) + off; }
        const int nig = WGM * nN, gid = wgid / nig, fm = gid * WGM, gsz = (nM - fm) < WGM ? (nM - fm) : WGM;
        u.pm = fm + ((wgid % nig) % gsz); u.pn = (wgid % nig) / gsz; u.job = 0;
    }
    __host__ __device__ bool next(int i, Unit& u) const {
        const long L = (long)i * G + c; if (L >= nwg) return false;
        map(L, u); return true;
    }
    __device__ __forceinline__ void a_ready(const Unit&) const {}
    __device__ __forceinline__ void done(const Unit&) const {}
};

struct DualOrder {
    StaticOrder o1, o2;
    __host__ __device__ void init(int M1, int N1, int M2, int N2, int G_, int c_) { o1.init(M1, N1, G_, c_); o2.init(M2, N2, G_, c_); }
    __host__ __device__ bool next(int i, Unit& u) const {
        const long L = (long)i * o1.G + o1.c;
        if (L < o1.nwg) { o1.map(L, u); return true; }
        if (L - o1.nwg >= o2.nwg) return false;
        o2.map(L - o1.nwg, u); u.job = 1; return true;
    }
    __device__ __forceinline__ void a_ready(const Unit&) const {}
    __device__ __forceinline__ void done(const Unit&) const {}
};
__device__ __forceinline__ unsigned cvt_pk_bf16(float lo, float hi) { unsigned r; asm volatile("v_cvt_pk_bf16_f32 %0, %1, %2" : "=v"(r) : "v"(lo), "v"(hi)); return r; }

struct EpiStore {
    static constexpr bool PERM = true, AFTER_DRAIN = false;
    bf16_t* O; int ldc;
    __device__ __forceinline__ void operator()(const f32x4 (&acc)[2][2][4][2], const Unit& u, int wr, int wc, int fr, int fq) const {
        const int row0 = u.pm * BM + wr * 64 + fr, col0 = u.pn * BM + wc * 32 + 8 * fq;
#pragma unroll
        for (int ai = 0; ai < 2; ++ai)
#pragma unroll
            for (int m = 0; m < 4; ++m) { bf16_t* rowp = O + (size_t)(row0 + ai * HALF + m * 16) * ldc + col0;
#pragma unroll
                for (int bj = 0; bj < 2; ++bj) { const f32x4 v0 = acc[ai][bj][m][0], v1 = acc[ai][bj][m][1];
                    u32x4 w; w.x = cvt_pk_bf16(v0[0], v0[1]); w.y = cvt_pk_bf16(v0[2], v0[3]); w.z = cvt_pk_bf16(v1[0], v1[1]); w.w = cvt_pk_bf16(v1[2], v1[3]);
                    *(u32x4*)(rowp + bj * HALF) = w; } }
    }
};
__device__ __forceinline__ float silu_mul(float g, float u) { return g * __builtin_amdgcn_rcpf(1.f + __builtin_amdgcn_exp2f(-1.4426950408889634f * g)) * u; }
struct EpiSwiglu {
    static constexpr bool PERM = true, AFTER_DRAIN = false;
    bf16_t* O; int ldc;
    __device__ __forceinline__ void operator()(const f32x4 (&acc)[2][2][4][2], const Unit& u, int wr, int wc, int fr, int fq) const {
        const int row0 = u.pm * BM + wr * 64 + fr, col0 = u.pn * HALF + wc * 32 + 8 * fq;
#pragma unroll
        for (int ai = 0; ai < 2; ++ai)
#pragma unroll
            for (int m = 0; m < 4; ++m) { bf16_t* rowp = O + (size_t)(row0 + ai * HALF + m * 16) * ldc + col0;
                const f32x4 g0 = acc[ai][0][m][0], g1 = acc[ai][0][m][1], u0 = acc[ai][1][m][0], u1 = acc[ai][1][m][1];
                u32x4 w; w.x = cvt_pk_bf16(silu_mul(g0[0], u0[0]), silu_mul(g0[1], u0[1])); w.y = cvt_pk_bf16(silu_mul(g0[2], u0[2]), silu_mul(g0[3], u0[3]));
                w.z = cvt_pk_bf16(silu_mul(g1[0], u1[0]), silu_mul(g1[1], u1[1])); w.w = cvt_pk_bf16(silu_mul(g1[2], u1[2]), silu_mul(g1[3], u1[3]));
                *(u32x4*)rowp = w; }
    }
};
struct EpiWin {
    static constexpr bool PERM = true, AFTER_DRAIN = false;
    bf16_t* O; int ldc; float* G; int gate_pn;
    __device__ __forceinline__ void operator()(const f32x4 (&acc)[2][2][4][2], const Unit& u, int wr, int wc, int fr, int fq) const {
        const int row0 = u.pm * BM + wr * 64 + fr, col0 = u.pn * BM + wc * 32 + 8 * fq;
        if (u.pn < gate_pn) {
#pragma unroll
            for (int ai = 0; ai < 2; ++ai)
#pragma unroll
                for (int m = 0; m < 4; ++m) { bf16_t* rowp = O + (size_t)(row0 + ai * HALF + m * 16) * ldc + col0;
#pragma unroll
                    for (int bj = 0; bj < 2; ++bj) { const f32x4 v0 = acc[ai][bj][m][0], v1 = acc[ai][bj][m][1];
                        u32x4 w; w.x = cvt_pk_bf16(v0[0], v0[1]); w.y = cvt_pk_bf16(v0[2], v0[3]); w.z = cvt_pk_bf16(v1[0], v1[1]); w.w = cvt_pk_bf16(v1[2], v1[3]);
                        *(u32x4*)(rowp + bj * HALF) = w; } }
        } else if (wc == 0 && fq < 2) {
#pragma unroll
            for (int ai = 0; ai < 2; ++ai)
#pragma unroll
                for (int m = 0; m < 4; ++m) { float* gp = G + (size_t)(row0 + ai * HALF + m * 16) * 16 + 8 * fq;
                    *(f32x4*)gp = acc[ai][0][m][0]; *(f32x4*)(gp + 4) = acc[ai][0][m][1]; }
        }
    }
};
struct EpiWinDual {
    static constexpr bool PERM = true, AFTER_DRAIN = false;
    EpiWin e1; EpiStore e2;
    __device__ __forceinline__ void operator()(const f32x4 (&acc)[2][2][4][2], const Unit& u, int wr, int wc, int fr, int fq) const {
        if (u.job) e2(acc, u, wr, wc, fr, fq); else e1(acc, u, wr, wc, fr, fq);
    }
};
struct EpiPool {
    static constexpr bool PERM = true, AFTER_DRAIN = false;
    bf16_t* O; int ldc; const float* scale;
    __device__ __forceinline__ void operator()(const f32x4 (&acc)[2][2][4][2], const Unit& u, int wr, int wc, int fr, int fq) const {
        const int row0 = u.pm * BM + wr * 64 + fr, col0 = u.pn * BM + wc * 32 + 8 * fq;
#pragma unroll
        for (int ai = 0; ai < 2; ++ai)
#pragma unroll
            for (int m = 0; m < 4; ++m) { bf16_t* rowp = O + (size_t)(row0 + ai * HALF + m * 16) * ldc + col0;
#pragma unroll
                for (int bj = 0; bj < 2; ++bj) { const f32x4 s0 = *(const f32x4*)(scale + col0 + bj * HALF), s1 = *(const f32x4*)(scale + col0 + bj * HALF + 4);
                    const f32x4 v0 = acc[ai][bj][m][0] * s0, v1 = acc[ai][bj][m][1] * s1;
                    u32x4 w; w.x = cvt_pk_bf16(v0[0], v0[1]); w.y = cvt_pk_bf16(v0[2], v0[3]); w.z = cvt_pk_bf16(v1[0], v1[1]); w.w = cvt_pk_bf16(v1[2], v1[3]);
                    *(u32x4*)(rowp + bj * HALF) = w; } }
    }
};


template <class Epi, class Sched, bool ALIGN_EPI = false, bool SP2 = false>
__device__ __forceinline__ void gemm_phase(PG8_LAS unsigned char* lds, const Gemm g, const Sched& S, const Epi& E) {
    const int tid = mytid(), wid = __builtin_amdgcn_readfirstlane(tid >> 6), lane = tid & 63, wr = wid >> 2, wc = wid & 3, fr = lane & 15, fq = lane >> 4;
    const int K = g.K, nt = K / BK;
    unsigned voffA[2], voffB[2];
#pragma unroll
    for (int i = 0; i < 2; ++i) { int R, C; stage_rc(tid * 16 + i * 8192, R, C); const int Rb = Epi::PERM ? ((R & ~31) + perm32(R & 31)) : R;
        voffA[i] = (unsigned)(R * K + C) * 2u; voffB[i] = (unsigned)(Rb * K + C) * 2u; }
    const size_t kstep = (size_t)(BK * 2);
    const size_t hstep = (size_t)HALF * K * 2;
    const size_t tstep = 2 * hstep;
    const unsigned ldsw = (unsigned)wid * 1024u;
    const int aoff = lds_byte(wr * 64 + fr, fq * 8), boff = lds_byte(wc * 32 + fr, fq * 8);
#define PG8_SA(b, h) (((b) * 2 + (h)) * HTB)
#define PG8_SB(b, h) ((4 + (b) * 2 + (h)) * HTB)
#define PG8_STAGE(bufoff, gbase, voff) do { _Pragma("unroll") for (int _i = 0; _i < 2; ++_i) \
        __builtin_amdgcn_global_load_lds((const unsigned*)((const char*)(gbase) + (voff)[_i]), (PG8_LAS unsigned*)(lds + (bufoff) + ldsw + _i * 8192), 16, 0, 0); } while (0)
#define PG8_LDA(dst, b, h) do { _Pragma("unroll") for (int m = 0; m < 4; ++m) _Pragma("unroll") for (int k = 0; k < 2; ++k) dst[m][k] = *(const PG8_LAS bf16x8*)(lds + PG8_SA(b, h) + aoff + m * 2048 + k * 1024); } while (0)
#define PG8_LDB(dst, b, h) do { _Pragma("unroll") for (int n = 0; n < 2; ++n) _Pragma("unroll") for (int k = 0; k < 2; ++k) dst[n][k] = *(const PG8_LAS bf16x8*)(lds + PG8_SB(b, h) + boff + n * 2048 + k * 1024); } while (0)
#define PG8_MMA(ai, bj, At, Bt) do { __builtin_amdgcn_s_setprio(1); _Pragma("unroll") for (int m = 0; m < 4; ++m) _Pragma("unroll") for (int n = 0; n < 2; ++n) _Pragma("unroll") for (int k = 0; k < 2; ++k) \
        acc[ai][bj][m][n] = __builtin_amdgcn_mfma_f32_16x16x32_bf16(Bt[n][k], At[m][k], acc[ai][bj][m][n], 0, 0, 0); __builtin_amdgcn_s_setprio(0); } while (0)
#define PG8_WAIT_V(n) asm volatile("s_waitcnt vmcnt(" #n ")" ::: "memory")
#define PG8_WAIT_L(n) asm volatile("s_waitcnt lgkmcnt(" #n ")" ::: "memory")
#define PG8_BAR __builtin_amdgcn_s_barrier()
#define PG8_SCHED __builtin_amdgcn_sched_barrier(0)
    Unit cur, nxt; int ui = 0;
    if (!S.next(0, cur)) return;
    f32x4 acc[2][2][4][2];
#pragma unroll
    for (int a = 0; a < 2; ++a)
#pragma unroll
        for (int b = 0; b < 2; ++b)
#pragma unroll
            for (int m = 0; m < 4; ++m)
#pragma unroll
                for (int n = 0; n < 2; ++n) acc[a][b][m][n] = (f32x4){0.f, 0.f, 0.f, 0.f};
    bf16x8 At[4][2], B0[2][2], B1[2][2];
    const char* cA = (const char*)(cur.job ? g.A2 : g.A) + (size_t)cur.pm * tstep; const char* cB = (const char*)(cur.job ? g.Bt2 : g.Bt) + (size_t)cur.pn * tstep;
    S.a_ready(cur);
    if constexpr (SP2) {
        PG8_STAGE(PG8_SB(0, 0), cB, voffB); PG8_STAGE(PG8_SB(0, 1), cB + hstep, voffB); PG8_STAGE(PG8_SA(0, 0), cA, voffA); PG8_STAGE(PG8_SA(0, 1), cA + hstep, voffA);
        if (wr == 1) PG8_BAR;
        PG8_WAIT_V(2); PG8_BAR;
        PG8_STAGE(PG8_SB(1, 0), cB + kstep, voffB); PG8_STAGE(PG8_SA(1, 0), cA + kstep, voffA); PG8_STAGE(PG8_SB(1, 1), cB + hstep + kstep, voffB);
        PG8_WAIT_V(6); PG8_BAR;
    } else {
        PG8_STAGE(PG8_SB(0, 0), cB, voffB); PG8_STAGE(PG8_SA(0, 0), cA, voffA); PG8_STAGE(PG8_SB(0, 1), cB + hstep, voffB); PG8_STAGE(PG8_SA(0, 1), cA + hstep, voffA);
        if (wr == 1) PG8_BAR;
        PG8_WAIT_V(4); PG8_BAR;
        PG8_STAGE(PG8_SB(1, 0), cB + kstep, voffB); PG8_STAGE(PG8_SA(1, 0), cA + kstep, voffA); PG8_STAGE(PG8_SB(1, 1), cB + hstep + kstep, voffB);
        PG8_WAIT_V(6); PG8_BAR;
    }
    for (;;) {
        const bool has_next = S.next(ui + 1, nxt);
        const char* nA = has_next ? (const char*)(nxt.job ? g.A2 : g.A) + (size_t)nxt.pm * tstep : cA; const char* nB = has_next ? (const char*)(nxt.job ? g.Bt2 : g.Bt) + (size_t)nxt.pn * tstep : cB;
        for (int t = 0; t < nt; t += 2) {
            const bool last = (t == nt - 2);
            const char* a1 = cA + (size_t)(t + 1) * kstep;
            const char* a2 = last ? nA : cA + (size_t)(t + 2) * kstep; const char* b2 = last ? nB : cB + (size_t)(t + 2) * kstep;
            const char* a3 = a2 + kstep; const char* b3 = b2 + kstep;
            if (last && has_next) S.a_ready(nxt);
            if constexpr (SP2) {
            PG8_LDB(B0, 0, 0); PG8_LDB(B1, 0, 1); PG8_SCHED; PG8_LDA(At, 0, 0); PG8_STAGE(PG8_SA(1, 1), a1 + hstep, voffA);
            PG8_WAIT_V(8); PG8_WAIT_L(0); PG8_BAR; PG8_MMA(0, 0, At, B0); PG8_MMA(0, 1, At, B1); PG8_BAR; PG8_SCHED;
            PG8_LDA(At, 0, 1); PG8_STAGE(PG8_SB(0, 0), b2, voffB); PG8_STAGE(PG8_SB(0, 1), b2 + hstep, voffB); PG8_STAGE(PG8_SA(0, 0), a2, voffA);
            PG8_WAIT_V(8); PG8_WAIT_L(0); PG8_BAR; PG8_MMA(1, 0, At, B0); PG8_MMA(1, 1, At, B1); PG8_BAR; PG8_SCHED;
            PG8_LDB(B0, 1, 0); PG8_LDB(B1, 1, 1); PG8_SCHED; PG8_LDA(At, 1, 0); PG8_STAGE(PG8_SA(0, 1), a2 + hstep, voffA);
            PG8_WAIT_V(8); PG8_WAIT_L(0); PG8_BAR; PG8_MMA(0, 0, At, B0); PG8_MMA(0, 1, At, B1); PG8_BAR; PG8_SCHED;
            PG8_LDA(At, 1, 1); PG8_STAGE(PG8_SB(1, 0), b3, voffB); PG8_STAGE(PG8_SB(1, 1), b3 + hstep, voffB); PG8_STAGE(PG8_SA(1, 0), a3, voffA);
            PG8_WAIT_V(8); PG8_WAIT_L(0); PG8_BAR; PG8_MMA(1, 0, At, B0); PG8_MMA(1, 1, At, B1); PG8_BAR; PG8_SCHED;
            } else {
            PG8_LDB(B0, 0, 0); PG8_SCHED; PG8_LDA(At, 0, 0); PG8_STAGE(PG8_SA(1, 1), a1 + hstep, voffA);
            PG8_WAIT_L(8); PG8_BAR; PG8_WAIT_L(0); PG8_MMA(0, 0, At, B0); PG8_BAR; PG8_SCHED;
            PG8_LDB(B1, 0, 1); PG8_STAGE(PG8_SB(0, 0), b2, voffB);
            PG8_BAR; PG8_WAIT_L(0); PG8_MMA(0, 1, At, B1); PG8_BAR;
            PG8_LDA(At, 0, 1); PG8_STAGE(PG8_SA(0, 0), a2, voffA);
            PG8_BAR; PG8_WAIT_L(0); PG8_MMA(1, 0, At, B0); PG8_BAR; PG8_SCHED;
            PG8_STAGE(PG8_SB(0, 1), b2 + hstep, voffB);
            PG8_WAIT_V(6); PG8_BAR; PG8_MMA(1, 1, At, B1); PG8_BAR;
            PG8_LDB(B0, 1, 0); PG8_SCHED; PG8_LDA(At, 1, 0); PG8_STAGE(PG8_SA(0, 1), a2 + hstep, voffA);
            PG8_WAIT_L(8); PG8_BAR; PG8_WAIT_L(0); PG8_MMA(0, 0, At, B0); PG8_BAR; PG8_SCHED;
            PG8_LDB(B1, 1, 1); PG8_STAGE(PG8_SB(1, 0), b3, voffB);
            PG8_BAR; PG8_WAIT_L(0); PG8_MMA(0, 1, At, B1); PG8_BAR;
            PG8_LDA(At, 1, 1); PG8_STAGE(PG8_SA(1, 0), a3, voffA);
            PG8_BAR; PG8_WAIT_L(0); PG8_MMA(1, 0, At, B0); PG8_BAR; PG8_SCHED;
            PG8_STAGE(PG8_SB(1, 1), b3 + hstep, voffB);
            PG8_WAIT_V(6); PG8_BAR; PG8_MMA(1, 1, At, B1); PG8_BAR;
            }
        }
        if constexpr (ALIGN_EPI) { if (wr == 0) PG8_BAR; }
        if constexpr (!Epi::AFTER_DRAIN) { E(acc, cur, wr, wc, fr, fq); S.done(cur); }
        if (!has_next) break;
#pragma unroll
        for (int a = 0; a < 2; ++a)
#pragma unroll
            for (int b = 0; b < 2; ++b)
#pragma unroll
                for (int m = 0; m < 4; ++m)
#pragma unroll
                    for (int n = 0; n < 2; ++n) acc[a][b][m][n] = (f32x4){0.f, 0.f, 0.f, 0.f};
        cur = nxt; cA = nA; cB = nB; ++ui;
        if constexpr (ALIGN_EPI) { if (wr == 1) PG8_BAR; }
    }
    PG8_WAIT_V(0);
    if constexpr (!ALIGN_EPI) { if (wr == 0) PG8_BAR; }
    PG8_BAR;
    if constexpr (Epi::AFTER_DRAIN) { E.fused(acc, cur, wr, wc, fr, fq, lds, wid, lane); S.done(cur); }
#undef PG8_SA
#undef PG8_SB
#undef PG8_STAGE
#undef PG8_LDA
#undef PG8_LDB
#undef PG8_MMA
#undef PG8_WAIT_V
#undef PG8_WAIT_L
#undef PG8_BAR
#undef PG8_SCHED
}}

#define LAS __attribute__((address_space(3)))
typedef unsigned short bf16_t;
typedef short bf16x8 __attribute__((ext_vector_type(8)));
typedef short s16x4 __attribute__((ext_vector_type(4)));
typedef float f32x4 __attribute__((ext_vector_type(4)));
typedef float f32x16 __attribute__((ext_vector_type(16)));
typedef unsigned u32x4 __attribute__((ext_vector_type(4)));
typedef unsigned u32x2 __attribute__((ext_vector_type(2)));
typedef float f32x2_t __attribute__((ext_vector_type(2)));
typedef __bf16 bf16x2_t __attribute__((ext_vector_type(2)));

constexpr int NB = 4, SEQ = 4096, M = NB * SEQ, D = 2048, FF = 5632, NIN = 5648, DEPTH = 2;
constexpr int NP = 4352, LDP = 4096, GATE_PN = 16, NV = 1536;
constexpr float EPS = 1e-6f, LOG2E = 1.4426950408889634f, QSCALE = 0.08838834764831845f;
constexpr int NWAVES = 8, NTHR = 512;
constexpr int LDS_BYTES = 155648;
constexpr int NPHASE = 1 + 11 * DEPTH;

constexpr size_t MiB = 1u << 20;
constexpr size_t WS_WL = 164 * MiB;
constexpr size_t W_BT1 = 0, W_WD1 = 44 * MiB, W_BT2 = 66 * MiB, W_WD2 = 110 * MiB, W_WIN = 132 * MiB, W_WV = 149 * MiB, W_WOUT = 155 * MiB, W_WPOOL = 163 * MiB;
constexpr size_t WS_XN = 328 * MiB, WS_XB = 392 * MiB  , WS_GATES = 456 * MiB, WS_ROWB = 457 * MiB, WS_COLB = 458 * MiB;
constexpr size_t WS_CMAXT = 457 * MiB + 768 * 1024;
constexpr size_t WS_RINV = 458 * MiB + 768 * 1024;
constexpr size_t WS_BAR = 459 * MiB, BAR_BYTES = 16384;
constexpr size_t WS_BIG = 460 * MiB;
constexpr size_t WS_P = WS_BIG, WS_VT = WS_BIG + 128 * MiB, WS_QK = WS_BIG + 176 * MiB, WS_DPOOL = WS_BIG + 208 * MiB, WS_CAT = WS_BIG + 224 * MiB;
constexpr size_t WS_END = WS_BIG + 288 * MiB;
constexpr size_t WS_H_FFN = WS_XB, WS_H_MIX = WS_XB;

__device__ __forceinline__ unsigned f2bf(float f) { unsigned u = __builtin_bit_cast(unsigned, f); return (u + 0x7fffu + ((u >> 16) & 1u)) >> 16; }
__device__ __forceinline__ unsigned pk2(float lo, float hi) { return f2bf(lo) | (f2bf(hi) << 16); }
__device__ __forceinline__ unsigned cvtpk(float lo, float hi) { f32x2_t v = {lo, hi}; bf16x2_t b = __builtin_convertvector(v, bf16x2_t); return __builtin_bit_cast(unsigned, b); }
__device__ __forceinline__ float bflo(unsigned w) { return __builtin_bit_cast(float, w << 16); }
__device__ __forceinline__ float bfhi(unsigned w) { return __builtin_bit_cast(float, w & 0xffff0000u); }
#define LDS_WAIT() asm volatile("s_waitcnt lgkmcnt(0)" ::: "memory")
__device__ __forceinline__ float wave_sum(float v) {
#pragma unroll
    for (int o = 1; o < 64; o <<= 1) v += __shfl_xor(v, o);
    return v;
}

typedef __attribute__((address_space(1))) unsigned gu32;
#define XB_TMO      128
#define XB_XCNT(j)  (256  + 64 * (j))
#define XB_XSUB(j)  (1280 + 64 * (j))
#define XB_XGEN(j)  (2304 + 64 * (j))
#define XB_TOP      3328
#define XB_TOPGEN   3392
#define XCD_BAR_WORDS 3456
#define XB_SPIN_CAP (1u << 18)

__device__ __forceinline__ unsigned xb_ld(unsigned* p)              { return __hip_atomic_load(p, __ATOMIC_RELAXED, __HIP_MEMORY_SCOPE_AGENT); }
__device__ __forceinline__ unsigned xb_add(unsigned* p, unsigned v) { return __hip_atomic_fetch_add(p, v, __ATOMIC_RELAXED, __HIP_MEMORY_SCOPE_AGENT); }
__device__ __forceinline__ unsigned xb_xcc_id() { return (unsigned)__builtin_amdgcn_s_getreg((3 << 11) | 20) & 0xFu; }
#define XB_SPIN(cond, bar) do { unsigned _sp = 0; while (cond) { __builtin_amdgcn_s_sleep(1); \
    if ((++_sp & 255u) == 0u) { if (xb_ld(&(bar)[XB_TMO])) break; if (_sp > XB_SPIN_CAP) { atomicAdd(&(bar)[XB_TMO], 1u); break; } } } } while (0)

struct XcdBarrier {
    unsigned* bar; unsigned x;
    volatile LAS unsigned* st;
};

__device__ __forceinline__ XcdBarrier xcd_barrier_post(unsigned* bar, volatile LAS unsigned* st) {
    XcdBarrier b; b.bar = bar; b.x = xb_xcc_id(); b.st = st;
    if (threadIdx.x == 0) (void)xb_add(&bar[XB_XCNT(b.x)], 1u);
    return b;
}
__device__ __forceinline__ void xcd_barrier_complete(unsigned* bar, unsigned x, unsigned& nloc, unsigned& nx) {
    const unsigned G = gridDim.x * gridDim.y * gridDim.z;
    unsigned sum, cnt, mine, sp = 0u;
    for (;;) {
        sum = 0u; cnt = 0u; mine = 0u;
#pragma unroll
        for (unsigned j = 0; j < 16; ++j) { const unsigned c = xb_ld(&bar[XB_XCNT(j)]); sum += c; cnt += (c > 0u) ? 1u : 0u; mine = (j == x) ? c : mine; }
        if (sum == G) break;
        __builtin_amdgcn_s_sleep(1);
        if ((++sp & 255u) == 0u) { if (xb_ld(&bar[XB_TMO])) break; if (sp > XB_SPIN_CAP) { atomicAdd(&bar[XB_TMO], 1u); break; } }
    }
    nloc = mine > 0u ? mine : 1u; nx = cnt > 0u ? cnt : 1u;
}

__device__ __forceinline__ void xcd_barrier(const XcdBarrier& b) {
    asm volatile("s_waitcnt vmcnt(0)" ::: "memory");
    __syncthreads();
    if (threadIdx.x == 0) {
        unsigned* bar = b.bar;
        __builtin_amdgcn_s_waitcnt(0);
        unsigned nloc = b.st[0], nx = b.st[1];
        if (nloc == 0u) { xcd_barrier_complete(bar, b.x, nloc, nx); b.st[0] = nloc; b.st[1] = nx; }
        const unsigned old = xb_add(&bar[XB_XSUB(b.x)], 1u);
        const unsigned gen = old / nloc;
        if (old + 1u == (gen + 1u) * nloc) {
            __builtin_amdgcn_fence(__ATOMIC_RELEASE, "agent");
            asm volatile("s_waitcnt vmcnt(0)" ::: "memory");
            const unsigned og = xb_add(&bar[XB_TOP], 1u);
            const unsigned tg = og / nx;
            if (og + 1u == (tg + 1u) * nx) xb_add(&bar[XB_TOPGEN], 1u);
            else XB_SPIN(xb_ld(&bar[XB_TOPGEN]) == tg, bar);
            __builtin_amdgcn_fence(__ATOMIC_ACQUIRE, "agent");
            xb_add(&bar[XB_XGEN(b.x)], 1u);
            asm volatile("s_waitcnt vmcnt(0)" ::: "memory");
        } else {
            XB_SPIN(xb_ld(&bar[XB_XGEN(b.x)]) == gen, bar);
            __builtin_amdgcn_fence(__ATOMIC_ACQUIRE, "agent");
            asm volatile("s_waitcnt vmcnt(0)" ::: "memory");
        }
    }
    __syncthreads();
}

__device__ __forceinline__ void grp_barrier(unsigned* ctr, unsigned target) {
    asm volatile("s_waitcnt vmcnt(0)" ::: "memory");
    __syncthreads();
    if (mytid() == 0) {
        __builtin_amdgcn_fence(__ATOMIC_RELEASE, "agent");
        asm volatile("s_waitcnt vmcnt(0)" ::: "memory");
        (void)__hip_atomic_fetch_add(ctr, 1u, __ATOMIC_RELAXED, __HIP_MEMORY_SCOPE_AGENT);
        unsigned sp = 0;
        while (__hip_atomic_load(ctr, __ATOMIC_RELAXED, __HIP_MEMORY_SCOPE_AGENT) < target) { __builtin_amdgcn_s_sleep(1); if (++sp > (1u << 22)) break; }
        __builtin_amdgcn_fence(__ATOMIC_ACQUIRE, "agent");
        asm volatile("s_waitcnt vmcnt(0)" ::: "memory");
    }
    __syncthreads();
}

struct Args { const float* in[22]; float* out; unsigned char* ws; int ph_lo, ph_hi; };

struct P0Item { const float* src; size_t ld, Kd; int k0, c0, r0; bf16_t* dst; const float* gk; };
struct P0Regs { float v[32]; float gl; };
__device__ __forceinline__ void tr_load(const P0Item& p, P0Regs& r, int lane) {
    r.gl = p.gk ? p.gk[p.k0 + lane] : 1.f;
#pragma unroll
    for (int i = 0; i < 32; ++i) { const int kk = 2 * i + (lane >> 5); r.v[i] = p.src[(size_t)(p.k0 + kk) * p.ld + p.c0 + (lane & 31)]; }
}
__device__ __forceinline__ void tr_store(const P0Item& p, const P0Regs& r, LAS float* scr, int lane) {
#pragma unroll
    for (int i = 0; i < 32; ++i) { const int kk = 2 * i + (lane >> 5); scr[kk * 33 + (lane & 31)] = r.v[i] * __shfl(r.gl, kk); }
    LDS_WAIT(); asm volatile("" ::: "memory");
    const int c = lane & 7;
#pragma unroll
    for (int j = 0; j < 4; ++j) { const int n = (lane >> 3) + 8 * j; const LAS float* s = scr + (8 * c) * 33 + n;
        u32x4 o; o.x = pk2(s[0 * 33], s[1 * 33]); o.y = pk2(s[2 * 33], s[3 * 33]); o.z = pk2(s[4 * 33], s[5 * 33]); o.w = pk2(s[6 * 33], s[7 * 33]);
        *(u32x4*)(p.dst + (size_t)(p.r0 + n) * p.Kd + p.k0 + 8 * c) = o; }
    LDS_WAIT(); asm volatile("" ::: "memory");
}

constexpr int IT_FF = 5632, IT_L = 6 * IT_FF + IT_FF + 2048 + 32;
__device__ __forceinline__ P0Item p0_decode(const Args& a, unsigned char* ws, int it) {
        const int l = it / IT_L; int r = it % IT_L;
        unsigned char* wl = ws + (size_t)l * WS_WL;
        const float* src; size_t ld, Kd; int k0, c0, r0; bf16_t* dst; const float* gk = nullptr;
        if (r < 6 * IT_FF) {
            const int f = r / (3 * IT_FF), r2 = r % (3 * IT_FF), mat = r2 / IT_FF, i = r2 % IT_FF;
            if (mat < 2) { const int kb = i / 176, nb = i % 176;
                src = a.in[f ? (mat ? 20 : 19) : (mat ? 4 : 3)] + (size_t)l * D * FF; ld = FF; k0 = kb * 64; c0 = nb * 32;
                dst = (bf16_t*)(wl + (f ? W_BT2 : W_BT1)); Kd = D; r0 = (nb >> 2) * 256 + (nb & 3) * 32 + mat * 128; gk = a.in[f ? 17 : 1] + (size_t)l * D;
            } else { const int kb = i / 64, nb = i % 64;
                src = a.in[f ? 21 : 5] + (size_t)l * FF * D; ld = D; k0 = kb * 64; c0 = nb * 32;
                dst = (bf16_t*)(wl + (f ? W_WD2 : W_WD1)); Kd = FF; r0 = nb * 32; }
        } else if (r < 7 * IT_FF) {
            const int i = r - 6 * IT_FF, kb = i / 176, j = i % 176;
            src = a.in[8] + (size_t)l * D * NIN; ld = NIN; k0 = kb * 64; Kd = D; gk = a.in[6] + (size_t)l * D;
            if (j < 128) { dst = (bf16_t*)(wl + W_WIN); r0 = j * 32;
                if (j < 32) c0 = j * 32;
                else if (j < 48) c0 = 1536 + (j - 32) * 32;
                else if (j < 64) c0 = 2056 + (j - 48) * 32;
                else if (j < 96) c0 = 2568 + (j - 64) * 32;
                else c0 = 3592 + (j - 96) * 32;
            } else { dst = (bf16_t*)(wl + W_WV);
                if (j < 144) { r0 = (j - 128) * 32; c0 = 1024 + (j - 128) * 32; }
                else { r0 = 512 + (j - 144) * 32; c0 = 4616 + (j - 144) * 32; } }
        } else if (r < 7 * IT_FF + 2048) {
            const int i = r - 7 * IT_FF, kb = i / 64, nb = i % 64;
            src = a.in[16] + (size_t)l * D * D; ld = D; k0 = kb * 64; c0 = nb * 32; dst = (bf16_t*)(wl + W_WOUT); Kd = D; r0 = nb * 32;
        } else {
            const int i = r - 7 * IT_FF - 2048, g = i >> 3, kb = (i >> 2) & 1, nb = i & 3;
            src = a.in[13] + (size_t)(l * 4 + g) * 128 * 128; ld = 128; k0 = kb * 64; c0 = nb * 32; dst = (bf16_t*)(wl + W_WPOOL) + g * 128; Kd = 512; r0 = g * 128 + nb * 32;
        }
        P0Item p; p.src = src; p.ld = ld; p.Kd = Kd; p.k0 = k0; p.c0 = c0; p.r0 = r0; p.dst = dst; p.gk = gk; return p;
}
__device__ __forceinline__ void p0_weights(const Args& a, LAS unsigned char* lds, int gw, int NGW, int wave, int lane) {
    LAS float* scr = (LAS float*)(lds + wave * 8704);
    unsigned char* ws = a.ws;
    if (gw < DEPTH * IT_L) {
        P0Item pc = p0_decode(a, ws, gw); P0Regs rc; tr_load(pc, rc, lane);
        for (int it = gw; it < DEPTH * IT_L; it += NGW) {
            const int itn = it + NGW; const bool more = itn < DEPTH * IT_L;
            P0Item pn = pc; P0Regs rn = rc;
            if (more) { pn = p0_decode(a, ws, itn); tr_load(pn, rn, lane); }
            tr_store(pc, rc, scr, lane);
            pc = pn; rc = rn;
        }
    }
    const int gt = gw * 64 + lane, NT = NGW * 64;
    for (int idx = gt; idx < DEPTH * 256 * D; idx += NT) {
        const int l = idx / (256 * D), rr = (idx / D) & 255, k = idx % D;
        float v = 0.f;
        if (rr < 8) v = a.in[8][(size_t)l * D * NIN + (size_t)k * NIN + 2048 + rr];
        else if (rr < 16) v = a.in[8][(size_t)l * D * NIN + (size_t)k * NIN + 5640 + (rr - 8)];
        ((bf16_t*)(ws + (size_t)l * WS_WL + W_WIN))[(size_t)(4096 + rr) * D + k] = (bf16_t)f2bf(v * a.in[6][(size_t)l * D + k]);
    }
    for (int idx = gt; idx < DEPTH * 512 * 512; idx += NT) {
        const int l = idx / (512 * 512), rr = (idx >> 9) & 511, c = idx & 511;
        if ((rr >> 7) != (c >> 7)) ((bf16_t*)(ws + (size_t)l * WS_WL + W_WPOOL))[rr * 512 + c] = 0;
    }
}

template <bool IN_F32, bool HAS_H, bool OUT_F32>
__device__ __forceinline__ void norm_rows(const void* xin, void* xout, const bf16_t* h, const float* post_g, float wgt, float* rinv, int m0, int mstep, int mend, int lane) {
    int m = m0; if (m >= mend) return;
    f32x4 nvf[IN_F32 ? 8 : 1]; u32x2 nvb[IN_F32 ? 1 : 8]; u32x2 nh[HAS_H ? 8 : 1]; float nri = 1.f;
#define NR_LOAD(mm) do { if (IN_F32) { const f32x4* xr = (const f32x4*)((const float*)xin + (size_t)(mm) * D) + lane; _Pragma("unroll") for (int j = 0; j < 8; ++j) nvf[IN_F32 ? j : 0] = xr[64 * j]; } \
        else { const u32x2* xr = (const u32x2*)((const bf16_t*)xin + (size_t)(mm) * D) + lane; _Pragma("unroll") for (int j = 0; j < 8; ++j) nvb[IN_F32 ? 0 : j] = xr[64 * j]; nri = rinv[mm]; } \
        if (HAS_H) { const u32x2* hr = (const u32x2*)(h + (size_t)(mm) * D) + lane; _Pragma("unroll") for (int j = 0; j < 8; ++j) nh[HAS_H ? j : 0] = hr[64 * j]; } } while (0)
    NR_LOAD(m);
    for (; m < mend; m += mstep) {
        f32x4 v[8]; u32x2 hw[8];
        const float ri = nri;
#pragma unroll
        for (int j = 0; j < 8; ++j) {
            if (IN_F32) v[j] = nvf[IN_F32 ? j : 0]; else { const u32x2 w = nvb[IN_F32 ? 0 : j]; v[j] = (f32x4){bflo(w.x), bfhi(w.x), bflo(w.y), bfhi(w.y)} * ri; }
            if (HAS_H) hw[j] = nh[HAS_H ? j : 0]; }
        const int mn = m + mstep;
        if (mn < mend) NR_LOAD(mn);
        if (HAS_H) {
            f32x4 hv[8]; float s = 0.f;
#pragma unroll
            for (int j = 0; j < 8; ++j) { const u32x2 w = hw[j]; hv[j] = (f32x4){bflo(w.x), bfhi(w.x), bflo(w.y), bfhi(w.y)};
                s += (hv[j][0] * hv[j][0] + hv[j][1] * hv[j][1]) + (hv[j][2] * hv[j][2] + hv[j][3] * hv[j][3]); }
            const float r = rsqrtf(wave_sum(s) * (1.f / D) + EPS) * wgt;
#pragma unroll
            for (int j = 0; j < 8; ++j) { const f32x4 g = ((const f32x4*)post_g)[64 * j + lane]; v[j] = v[j] + hv[j] * r * g; }
        }
        if (OUT_F32) { f32x4* xo = (f32x4*)((float*)xout + (size_t)m * D) + lane;
#pragma unroll
            for (int j = 0; j < 8; ++j) xo[64 * j] = v[j];
        } else {
            float s2 = 0.f;
#pragma unroll
            for (int j = 0; j < 8; ++j) s2 += (v[j][0] * v[j][0] + v[j][1] * v[j][1]) + (v[j][2] * v[j][2] + v[j][3] * v[j][3]);
            const float ms = wave_sum(s2) * (1.f / D) + EPS, r2 = rsqrtf(ms);
            if (lane == 0) rinv[m] = sqrtf(ms);
            u32x2* o8 = (u32x2*)((bf16_t*)xout + (size_t)m * D) + lane;
#pragma unroll
            for (int j = 0; j < 8; ++j) { const f32x4 y = v[j] * r2; u32x2 w; w.x = pk2(y[0], y[1]); w.y = pk2(y[2], y[3]); o8[64 * j] = w; }
        }
    }
#undef NR_LOAD
}

__device__ __forceinline__ void unpack8(const u32x4 w, float* f) { f[0] = bflo(w.x); f[1] = bfhi(w.x); f[2] = bflo(w.y); f[3] = bfhi(w.y); f[4] = bflo(w.z); f[5] = bfhi(w.z); f[6] = bflo(w.w); f[7] = bfhi(w.w); }
__device__ __forceinline__ float logsig(float x) { return fminf(x, 0.f) - log1pf(expf(-fabsf(x))); }
__device__ __forceinline__ void prep_phase(const Args& a, int l, LAS unsigned char* lds) {
    unsigned char* ws = a.ws;
    const bf16_t* P = (const bf16_t*)(ws + WS_P);
    bf16_t* QK = (bf16_t*)(ws + WS_QK); bf16_t* DP = (bf16_t*)(ws + WS_DPOOL);
    const float* conv = a.in[9] + (size_t)l * 4 * 1024;
    const int tid0 = mytid(); const int gt = blockIdx.x * NTHR + tid0, NT = gridDim.x * NTHR;
    for (int idx = gt; idx < (M / 16) * 128; idx += NT) {
        const int c8 = (idx & 127) * 8, tok0 = (idx >> 7) * 16; const bool head = ((tok0 & (SEQ - 1)) == 0);
        u32x4 rows[19];
#pragma unroll
        for (int i = 0; i < 19; ++i) { const bool valid = (i >= 3) || !head; const int r = valid ? tok0 - 3 + i : tok0;
            const u32x4 w = *(const u32x4*)(P + (size_t)r * LDP + c8); rows[i] = valid ? w : (u32x4){0u, 0u, 0u, 0u}; }
        float wj[4][8];
#pragma unroll
        for (int j = 0; j < 4; ++j) { const f32x4 w0 = *(const f32x4*)(conv + j * 1024 + c8), w1 = *(const f32x4*)(conv + j * 1024 + c8 + 4);
#pragma unroll
            for (int e = 0; e < 4; ++e) { wj[j][e] = w0[e]; wj[j][4 + e] = w1[e]; } }
#pragma unroll
        for (int tt = 0; tt < 16; ++tt) {
            float acc[8];
#pragma unroll
            for (int e = 0; e < 8; ++e) acc[e] = 0.f;
#pragma unroll
            for (int j = 0; j < 4; ++j) { float u[8]; unpack8(rows[tt + 3 - j], u);
#pragma unroll
                for (int e = 0; e < 8; ++e) acc[e] += u[e] * wj[j][e]; }
#pragma unroll
            for (int e = 0; e < 8; ++e) acc[e] = acc[e] / (1.f + __expf(-acc[e]));
            u32x4 o; o.x = pk2(acc[0], acc[1]); o.y = pk2(acc[2], acc[3]); o.z = pk2(acc[4], acc[5]); o.w = pk2(acc[6], acc[7]);
            *(u32x4*)(QK + (size_t)(tok0 + tt) * 1024 + c8) = o;
        }
    }
    for (int idx = gt; idx < M * 64; idx += NT) {
        const int ln = idx & 63, widx = idx >> 6, g = __builtin_amdgcn_readfirstlane(widx & 3), tok = (widx >> 2) * 4 + (ln >> 4), c8 = g * 128 + (ln & 15) * 8, t = tok & (SEQ - 1);
        const int win = 2 << g, n = (t + 1 < win) ? (t + 1) : win;
        float acc[8], u0[8];
        { const u32x4 w = *(const u32x4*)(P + (size_t)tok * LDP + 1536 + c8); unpack8(w, u0); }
#pragma unroll
        for (int e = 0; e < 8; ++e) acc[e] = u0[e];
#define POOL_TAPS(W) do { u32x4 rw[W - 1]; _Pragma("unroll") for (int j = 1; j < W; ++j) { const int r = (j < n) ? tok - j : tok; rw[j - 1] = *(const u32x4*)(P + (size_t)r * LDP + 1536 + c8); } \
            _Pragma("unroll") for (int j = 1; j < W; ++j) { float u[8]; unpack8(rw[j - 1], u); const float mk = (j < n) ? 1.f : 0.f; _Pragma("unroll") for (int e = 0; e < 8; ++e) acc[e] += u[e] * mk; } } while (0)
        if (g == 0) POOL_TAPS(2); else if (g == 1) POOL_TAPS(4); else if (g == 2) POOL_TAPS(8); else POOL_TAPS(16);
#undef POOL_TAPS
        const float inv = 1.f / (float)n;
#pragma unroll
        for (int e = 0; e < 8; ++e) acc[e] = acc[e] * inv - u0[e];
        u32x4 o; o.x = pk2(acc[0], acc[1]); o.y = pk2(acc[2], acc[3]); o.z = pk2(acc[4], acc[5]); o.w = pk2(acc[6], acc[7]);
        *(u32x4*)(DP + (size_t)tok * 512 + c8) = o;
    }
    {   unsigned* kn = (unsigned*)(ws + WS_BAR) + 3968 + 32 * l;
        for (int idx = gt; idx < M * 8; idx += NT) {
            const int tok = idx >> 3, h = idx & 7; const bf16_t* kp = P + (size_t)tok * LDP + 3072 + h * 128; float ss = 0.f;
#pragma unroll
            for (int c = 0; c < 16; ++c) { const u32x4 w = *(const u32x4*)(kp + c * 8); float u[8]; unpack8(w, u);
#pragma unroll
                for (int e = 0; e < 8; ++e) ss += u[e] * u[e]; }
            ss = fmaxf(ss, __shfl_xor(ss, 8)); ss = fmaxf(ss, __shfl_xor(ss, 16)); ss = fmaxf(ss, __shfl_xor(ss, 32));
            if ((tid0 & 63) < 8) atomicMax(&kn[(tok >> 12) * 8 + h], __float_as_uint(ss));
        }
    }
    if (blockIdx.x < NB * 12) {
        const int seq = blockIdx.x, b = seq / 12, hh = seq % 12, tid = tid0, lane = tid & 63, wv = tid >> 6;
        const float* G = (const float*)(ws + WS_GATES);
        float* rowb = (float*)(ws + WS_ROWB) + (size_t)seq * SEQ; float* colb = (float*)(ws + WS_COLB) + (size_t)seq * SEQ;
        const float bi = (hh < 4) ? a.in[10][l * 4 + hh] : 0.f;
        const float bf = (hh < 4) ? a.in[11][l * 4 + hh] : a.in[15][l * 8 + (hh - 4)];
        const int gi = (hh < 4) ? hh : 0, gf = (hh < 4) ? 4 + hh : 8 + (hh - 4);
        double loc[8]; float iv[8]; double run = 0.0;
#pragma unroll
        for (int e = 0; e < 8; ++e) { const float* g = G + (size_t)(b * SEQ + tid * 8 + e) * 16;
            iv[e] = g[gi] + bi; run += (double)logsig(g[gf] + bf); loc[e] = run; }
        double incl = run;
#pragma unroll
        for (int o = 1; o < 64; o <<= 1) { const double t2 = __shfl_up(incl, o); if (lane >= o) incl += t2; }
        LAS double* sh = (LAS double*)lds;
        __syncthreads();
        if (lane == 63) sh[wv] = incl;
        __syncthreads();
        double off = incl - run;
        for (int w2 = 0; w2 < wv; ++w2) off += sh[w2];
        float cb[8]; float tmax = -INFINITY;
#pragma unroll
        for (int e = 0; e < 8; ++e) { const double c = loc[e] + off; const int pos = tid * 8 + e;
            rowb[pos] = (float)(c * (double)LOG2E);
            cb[e] = (hh < 4) ? (float)(((double)iv[e] - c) * (double)LOG2E) : (float)(-c * (double)LOG2E); tmax = fmaxf(tmax, cb[e]); }
        if (hh < 4) {
            tmax = fmaxf(tmax, __shfl_xor(tmax, 1)); tmax = fmaxf(tmax, __shfl_xor(tmax, 2)); tmax = fmaxf(tmax, __shfl_xor(tmax, 4));
#pragma unroll
            for (int e = 0; e < 8; ++e) colb[tid * 8 + e] = exp2f(cb[e] - tmax);
            if ((tid & 7) == 0) ((float*)(ws + WS_CMAXT))[(size_t)seq * 64 + (tid >> 3)] = tmax;
        } else {
#pragma unroll
            for (int e = 0; e < 8; ++e) colb[tid * 8 + e] = cb[e];
        }
        __syncthreads();
    }
}

constexpr int AT_SLOT = 16384, AT_NK = 4, AT_NV = 4, AT_KOFF = 0, AT_VOFF = AT_NK * AT_SLOT, AT_COFF = AT_VOFF + AT_NV * AT_SLOT, AT_CMOFF = AT_COFF + 16384;
constexpr float AT_THR = 8.f;
#define MFMA32(a, b, c) __builtin_amdgcn_mfma_f32_32x32x16_bf16((a), (b), (c), 0, 0, 0)
#define AT_SB() __builtin_amdgcn_sched_barrier(0)

struct AttnSt { bf16x8 qf[8]; f32x16 o[4]; bf16x8 pbp[4]; float m, lsum; };

template <int MODE, bool DO_QK, bool DO_SM, bool DO_PV, bool MASK, bool DO_LD, bool LAST>
__device__ __forceinline__ void attn_body(AttnSt& st, LAS unsigned char* lds, int i, int v3, int nt, const bf16_t* __restrict__ kgp, int pitch, const bf16_t* __restrict__ vgp,
                                          float rb, unsigned kbase, unsigned vbase, int wofs, int hi, int qi) {
    if (DO_LD) {
        const int tK = nt - 1 - ((i + 3 < nt) ? i + 3 : nt - 1), tV = nt - 1 - ((i + 2 < nt) ? i + 2 : nt - 1);
        const bf16_t* gk = kgp + (size_t)(tK * 64) * pitch; const bf16_t* gv = vgp + tV * 64;
        LAS unsigned char* dk = lds + AT_KOFF + ((i + 3) & 3) * AT_SLOT + wofs; LAS unsigned char* dv = lds + AT_VOFF + ((i + 2) & 3) * AT_SLOT + wofs;
        __builtin_amdgcn_global_load_lds((const unsigned*)gk, (LAS unsigned*)dk, 16, 0, 0);
        __builtin_amdgcn_global_load_lds((const unsigned*)(gk + (size_t)32 * pitch), (LAS unsigned*)(dk + 8192), 16, 0, 0);
        __builtin_amdgcn_global_load_lds((const unsigned*)gv, (LAS unsigned*)dv, 16, 0, 0);
        __builtin_amdgcn_global_load_lds((const unsigned*)(gv + (size_t)64 * M), (LAS unsigned*)(dv + 8192), 16, 0, 0);
    }
    LAS const unsigned char* Kb = lds + AT_KOFF + (i & 3) * AT_SLOT;
    LAS const unsigned char* Vb = lds + AT_VOFF + ((i - 1) & 3) * AT_SLOT;
    const int k0 = (nt - 1 - i) * 64;
    LAS const unsigned char* Cb = lds + AT_COFF + (k0 + 8 * hi) * 4;
    f32x16 sn0, sn1;
    bf16x8 fa[4], fb[4];
#define AT_KLD(F, b) do { F[0] = *(LAS const bf16x8*)(Kb + (kbase ^ ((2 * (b)) << 5))); F[1] = *(LAS const bf16x8*)(Kb + 8192 + (kbase ^ ((2 * (b)) << 5))); \
                          F[2] = *(LAS const bf16x8*)(Kb + (kbase ^ ((2 * (b) + 1) << 5))); F[3] = *(LAS const bf16x8*)(Kb + 8192 + (kbase ^ ((2 * (b) + 1) << 5))); } while (0)
#define AT_KMM(F, b) do { sn0 = MFMA32(F[0], st.qf[2 * (b)], sn0); sn1 = MFMA32(F[1], st.qf[2 * (b)], sn1); sn0 = MFMA32(F[2], st.qf[2 * (b) + 1], sn0); sn1 = MFMA32(F[3], st.qf[2 * (b) + 1], sn1); } while (0)
#define AT_VLD(F, g) do { _Pragma("unroll") for (int d_ = 0; d_ < 4; ++d_) F[d_] = *(LAS const bf16x8*)(Vb + d_ * 4096 + (vbase ^ ((g) << 5))); } while (0)
#define AT_VMM(F, g) do { _Pragma("unroll") for (int d_ = 0; d_ < 4; ++d_) st.o[d_] = MFMA32(F[d_], st.pbp[g], st.o[d_]); } while (0)
    if (DO_QK) {
#pragma unroll
        for (int r = 0; r < 16; ++r) { sn0[r] = 0.f; sn1[r] = 0.f; }
        AT_KLD(fa, 0); AT_SB();
        AT_KLD(fb, 1); AT_KMM(fa, 0); AT_SB();
        AT_KLD(fa, 2); AT_KMM(fb, 1); AT_SB();
        AT_KLD(fb, 3); AT_KMM(fa, 2); AT_SB();
        if (DO_PV) AT_VLD(fa, 0);
        AT_KMM(fb, 3); AT_SB();
    } else if (DO_PV) { AT_VLD(fa, 0); AT_SB(); }
    float alpha = 1.f, mn = 0.f, mx = 0.f, ps = 0.f, rowfac = 0.f; bool need = false;
    f32x16& z0 = sn0; f32x16& z1 = sn1;
    if (DO_PV) { AT_VLD(fb, 1); AT_VMM(fa, 0); }
    if (DO_SM) {
        if (MODE == 0) {
#pragma unroll
            for (int h2 = 0; h2 < 2; ++h2) {
                const f32x4 c0a = *(LAS const f32x4*)(Cb + (16 * h2) * 4), c0b = *(LAS const f32x4*)(Cb + (16 * h2 + 4) * 4);
                const f32x4 c1a = *(LAS const f32x4*)(Cb + (32 + 16 * h2) * 4), c1b = *(LAS const f32x4*)(Cb + (32 + 16 * h2 + 4) * 4);
#pragma unroll
                for (int e = 0; e < 4; ++e) {
                    z0[8 * h2 + e] = fmaf(z0[8 * h2 + e], QSCALE * LOG2E, c0a[e]); z0[8 * h2 + 4 + e] = fmaf(z0[8 * h2 + 4 + e], QSCALE * LOG2E, c0b[e]);
                    z1[8 * h2 + e] = fmaf(z1[8 * h2 + e], QSCALE * LOG2E, c1a[e]); z1[8 * h2 + 4 + e] = fmaf(z1[8 * h2 + 4 + e], QSCALE * LOG2E, c1b[e]); }
            }
            if (MASK) {
#pragma unroll
                for (int r = 0; r < 16; ++r) { const int key = k0 + 16 * (r >> 3) + 8 * hi + (r & 7);
                    if (key > qi) z0[r] = -INFINITY;
                    if (key + 32 > qi) z1[r] = -INFINITY; }
            }
            mx = fmaxf(z0[0], z1[0]);
#pragma unroll
            for (int r = 1; r < 16; ++r) mx = fmaxf(mx, fmaxf(z0[r], z1[r]));
            { auto rr = __builtin_amdgcn_permlane32_swap(__float_as_uint(mx), __float_as_uint(mx), false, false); mx = fmaxf(__uint_as_float(rr[0]), __uint_as_float(rr[1])); }
        } else {
            mx = rb + *(LAS const float*)(lds + AT_CMOFF + (nt - 1 - i) * 4);
        }
        need = !__all(mx <= st.m + AT_THR);
        mn = need ? fmaxf(st.m, mx) : st.m;
        alpha = need ? __builtin_amdgcn_exp2f(st.m - mn) : 1.f; st.m = mn;
        if (MODE == 1) rowfac = QSCALE * __builtin_amdgcn_exp2f(mx - mn);
    }
    AT_SB();
    if (DO_PV) { AT_VLD(fa, 2); AT_VMM(fb, 1); }
    if (DO_SM) {
        if (MODE == 0) {
#pragma unroll
            for (int r = 0; r < 16; ++r) { const float p0 = __builtin_amdgcn_exp2f(z0[r] - mn); z0[r] = p0; ps += p0; }
        } else {
#pragma unroll
            for (int h2 = 0; h2 < 2; ++h2) { const f32x4 ca = *(LAS const f32x4*)(Cb + (16 * h2) * 4), cb4 = *(LAS const f32x4*)(Cb + (16 * h2 + 4) * 4);
#pragma unroll
                for (int e = 0; e < 8; ++e) { const int r = 8 * h2 + e; float p0 = z0[r] * ((e < 4 ? ca[e & 3] : cb4[e & 3]) * rowfac);
                    if (MASK) { if (k0 + 16 * h2 + 8 * hi + e > qi) p0 = 0.f; }
                    z0[r] = p0; ps += p0; } }
        }
    }
    AT_SB();
    if (DO_PV) { AT_VLD(fb, 3); AT_VMM(fa, 2); }
    if (DO_SM) {
        if (MODE == 0) {
#pragma unroll
            for (int r = 0; r < 16; ++r) { const float p1 = __builtin_amdgcn_exp2f(z1[r] - mn); z1[r] = p1; ps += p1; }
        } else {
#pragma unroll
            for (int h2 = 0; h2 < 2; ++h2) { const f32x4 ca = *(LAS const f32x4*)(Cb + (32 + 16 * h2) * 4), cb4 = *(LAS const f32x4*)(Cb + (32 + 16 * h2 + 4) * 4);
#pragma unroll
                for (int e = 0; e < 8; ++e) { const int r = 8 * h2 + e; float p1 = z1[r] * ((e < 4 ? ca[e & 3] : cb4[e & 3]) * rowfac);
                    if (MASK) { if (k0 + 32 + 16 * h2 + 8 * hi + e > qi) p1 = 0.f; }
                    z1[r] = p1; ps += p1; } }
        }
    }
    AT_SB();
    if (DO_PV) { AT_VMM(fb, 3); AT_SB(); }
    if (DO_SM) {
        st.lsum = st.lsum * alpha + ps;
#pragma unroll
        for (int j = 0; j < 2; ++j) {
            u32x4 w0 = {cvtpk(z0[8 * j + 0], z0[8 * j + 1]), cvtpk(z0[8 * j + 2], z0[8 * j + 3]), cvtpk(z0[8 * j + 4], z0[8 * j + 5]), cvtpk(z0[8 * j + 6], z0[8 * j + 7])};
            u32x4 w1 = {cvtpk(z1[8 * j + 0], z1[8 * j + 1]), cvtpk(z1[8 * j + 2], z1[8 * j + 3]), cvtpk(z1[8 * j + 4], z1[8 * j + 5]), cvtpk(z1[8 * j + 6], z1[8 * j + 7])};
            st.pbp[j] = __builtin_bit_cast(bf16x8, w0); st.pbp[2 + j] = __builtin_bit_cast(bf16x8, w1);
        }
        if (need) {
#pragma unroll
            for (int d = 0; d < 4; ++d)
#pragma unroll
                for (int r = 0; r < 16; ++r) st.o[d][r] *= alpha;
        }
    }
    if (LAST) asm volatile("s_waitcnt vmcnt(0) lgkmcnt(0)" ::: "memory"); else asm volatile("s_waitcnt vmcnt(8) lgkmcnt(0)" ::: "memory");
    __builtin_amdgcn_s_barrier();
#undef AT_KLD
#undef AT_KMM
#undef AT_VLD
#undef AT_VMM
}

template <int MODE>
__device__ __forceinline__ void attn_unit(LAS unsigned char* lds, const bf16_t* __restrict__ Q, const bf16_t* __restrict__ K, int pitch, const bf16_t* __restrict__ Vt,
                                          const float* __restrict__ rowb, const float* __restrict__ colb, const float* __restrict__ cmaxt, bf16_t* O, const bf16_t* MO, const float* hg, int qb, float kn2) {
    const int tid = mytid(), w = __builtin_amdgcn_readfirstlane(tid >> 6), lane = tid & 63, q32 = lane & 31, hi = lane >> 5;
    const int r0 = qb * 256 + w * 32, qi = r0 + q32;
    AttnSt st;
#pragma unroll
    for (int db = 0; db < 8; ++db) st.qf[db] = *(const bf16x8*)(Q + (size_t)qi * pitch + db * 16 + hi * 8);
    const float rb = rowb[qi], cref = rowb[qb * 256];
    const int nt = 4 * (qb + 1);
    const int kr = 4 * w + (lane >> 4), krow = (kr & ~15) | ((kr & 4) << 1) | ((kr & 8) >> 1) | (kr & 3), kch = (lane & 15) ^ (kr & 15);
    const bf16_t* kgp = K + (size_t)krow * pitch + kch * 8;
    const int vr = 8 * w + (lane >> 3), vgr = (lane & 7) ^ ((vr >> 1) & 7);
    const bf16_t* vgp = Vt + (size_t)vr * M + vgr * 8;
    const int wofs = w * 1024;
    const int x = q32 & 15, y = (q32 >> 1) & 7;
    const unsigned kbase = q32 * 256 + ((hi ^ (x & 1)) << 4) + ((x >> 1) << 5);
    const unsigned vbase = q32 * 128 + ((hi ^ (y & 1)) << 4) + ((y >> 1) << 5);
    st.m = -1e30f; st.lsum = 0.f;
#pragma unroll
    for (int d = 0; d < 4; ++d)
#pragma unroll
        for (int r = 0; r < 16; ++r) st.o[d][r] = 0.f;
    {
        const bf16_t* gk0 = kgp + (size_t)((nt - 1) * 64) * pitch; const bf16_t* gk1 = kgp + (size_t)((nt - 2) * 64) * pitch; const bf16_t* gv0 = vgp + (nt - 1) * 64;
        LAS unsigned char* dk = lds + AT_KOFF + wofs; LAS unsigned char* dv = lds + AT_VOFF + wofs;
        __builtin_amdgcn_global_load_lds((const unsigned*)gk0, (LAS unsigned*)dk, 16, 0, 0);
        __builtin_amdgcn_global_load_lds((const unsigned*)(gk0 + (size_t)32 * pitch), (LAS unsigned*)(dk + 8192), 16, 0, 0);
        __builtin_amdgcn_global_load_lds((const unsigned*)gk1, (LAS unsigned*)(dk + AT_SLOT), 16, 0, 0);
        __builtin_amdgcn_global_load_lds((const unsigned*)(gk1 + (size_t)32 * pitch), (LAS unsigned*)(dk + AT_SLOT + 8192), 16, 0, 0);
        __builtin_amdgcn_global_load_lds((const unsigned*)gv0, (LAS unsigned*)dv, 16, 0, 0);
        __builtin_amdgcn_global_load_lds((const unsigned*)(gv0 + (size_t)64 * M), (LAS unsigned*)(dv + 8192), 16, 0, 0);
        { const bf16_t* gk2 = kgp + (size_t)((nt - 3) * 64) * pitch; const bf16_t* gv1 = vgp + (nt - 2) * 64;
          __builtin_amdgcn_global_load_lds((const unsigned*)gk2, (LAS unsigned*)(dk + 2 * AT_SLOT), 16, 0, 0);
          __builtin_amdgcn_global_load_lds((const unsigned*)(gk2 + (size_t)32 * pitch), (LAS unsigned*)(dk + 2 * AT_SLOT + 8192), 16, 0, 0);
          __builtin_amdgcn_global_load_lds((const unsigned*)gv1, (LAS unsigned*)(dv + AT_SLOT), 16, 0, 0);
          __builtin_amdgcn_global_load_lds((const unsigned*)(gv1 + (size_t)64 * M), (LAS unsigned*)(dv + AT_SLOT + 8192), 16, 0, 0); }
        for (int idx = tid; idx < nt * 16; idx += NTHR) { f32x4 c4 = *(const f32x4*)(colb + idx * 4); if (MODE == 0) c4 = c4 + cref; *(LAS f32x4*)(lds + AT_COFF + idx * 16) = c4; }
        if (MODE == 1) { if (tid < nt) *(LAS float*)(lds + AT_CMOFF + tid * 4) = cmaxt[tid]; }
        asm volatile("s_waitcnt vmcnt(0) lgkmcnt(0)" ::: "memory");
        __builtin_amdgcn_s_barrier();
    }
#define AT_ARGS lds, i, v3, nt, kgp, pitch, vgp, rb, kbase, vbase, wofs, hi, qi
    int v3 = 0;
    { const int i = 0; attn_body<MODE, true, true, false, true, true, false>(st, AT_ARGS); v3 = 1; }
    for (int i = 1; i <= 3; ++i) { attn_body<MODE, true, true, true, true, true, false>(st, AT_ARGS); v3 = (v3 == 2) ? 0 : v3 + 1; }
    int i_end = nt;
    if (MODE == 0) {
        float q2 = 0.f;
#pragma unroll
        for (int db = 0; db < 8; ++db) { const u32x4 w = __builtin_bit_cast(u32x4, st.qf[db]); float u[8]; unpack8(w, u);
#pragma unroll
            for (int e = 0; e < 8; ++e) q2 += u[e] * u[e]; }
        { auto rr = __builtin_amdgcn_permlane32_swap(__float_as_uint(q2), __float_as_uint(q2), false, false); q2 = __uint_as_float(rr[0]) + __uint_as_float(rr[1]); }
        float mlo = st.m;
#pragma unroll
        for (int o = 1; o < 32; o <<= 1) { q2 = fmaxf(q2, __shfl_xor(q2, o)); mlo = fminf(mlo, __shfl_xor(mlo, o)); }
        LAS float* ex = (LAS float*)(lds + AT_CMOFF + 256);
        if (lane == 0) { ex[2 * w] = q2; ex[2 * w + 1] = mlo; }
        asm volatile("s_waitcnt lgkmcnt(0)" ::: "memory");
        __builtin_amdgcn_s_barrier();
        float q2u = ex[0], mlu = ex[1];
#pragma unroll
        for (int j = 1; j < 8; ++j) { q2u = fmaxf(q2u, ex[2 * j]); mlu = fminf(mlu, ex[2 * j + 1]); }
        const float sb = sqrtf(q2u * kn2) * (QSCALE * LOG2E) * 1.001f;
        const int ic = 4 + lane;
        bool dead = false;
        if (ic <= nt - 1) { const float ctop = *(LAS const float*)(lds + AT_COFF + ((nt - 1 - ic) * 64 + 63) * 4); dead = (sb + ctop - mlu) < -160.f; }
        const unsigned long long bal = __ballot(dead);
        if (bal) i_end = 4 + (int)__builtin_ctzll(bal);
    }
    for (int i = 4; i <= i_end - 1; ++i) { attn_body<MODE, true, true, true, false, true, false>(st, AT_ARGS); v3 = (v3 == 2) ? 0 : v3 + 1; }
    { const int i = i_end; attn_body<MODE, false, false, true, false, false, true>(st, AT_ARGS); }
#undef AT_ARGS
    float ltot;
    { auto rr = __builtin_amdgcn_permlane32_swap(__float_as_uint(st.lsum), __float_as_uint(st.lsum), false, false); ltot = __uint_as_float(rr[0]) + __uint_as_float(rr[1]); }
    float inv;
    if (MODE == 0) inv = 1.f / ltot;
    else {
        inv = 1.f / fmaxf(fabsf(ltot), __builtin_amdgcn_exp2f(-st.m));
        float ss = 0.f;
#pragma unroll
        for (int d = 0; d < 4; ++d)
#pragma unroll
            for (int r = 0; r < 16; ++r) { const float hv = st.o[d][r] * inv; ss += hv * hv; }
        { auto rr = __builtin_amdgcn_permlane32_swap(__float_as_uint(ss), __float_as_uint(ss), false, false); ss = __uint_as_float(rr[0]) + __uint_as_float(rr[1]); }
        inv *= rsqrtf(ss * (1.f / 128.f) + EPS);
    }
#pragma unroll
    for (int dbk = 0; dbk < 4; ++dbk)
#pragma unroll
        for (int g = 0; g < 4; ++g) {
            const int d = dbk * 32 + 8 * g + 4 * hi;
            float v0 = st.o[dbk][4 * g + 0] * inv, v1 = st.o[dbk][4 * g + 1] * inv, v2 = st.o[dbk][4 * g + 2] * inv, v3o = st.o[dbk][4 * g + 3] * inv;
            if (MODE == 1) {
                const f32x4 gg = *(const f32x4*)(hg + d); const u32x2 mo = *(const u32x2*)(MO + (size_t)qi * LDP + d);
                v0 *= gg[0] / (1.f + __expf(-bflo(mo.x))); v1 *= gg[1] / (1.f + __expf(-bfhi(mo.x)));
                v2 *= gg[2] / (1.f + __expf(-bflo(mo.y))); v3o *= gg[3] / (1.f + __expf(-bfhi(mo.y)));
            }
            u32x2 wv; wv.x = cvtpk(v0, v1); wv.y = cvtpk(v2, v3o);
            *(u32x2*)(O + (size_t)qi * D + d) = wv;
        }
}

__device__ __forceinline__ void attn_dispatch(const Args& a, int l, LAS unsigned char* lds, int bh, int qb) {
    unsigned char* ws = a.ws;
    const bf16_t* P = (const bf16_t*)(ws + WS_P); const bf16_t* QK = (const bf16_t*)(ws + WS_QK); const bf16_t* VT = (const bf16_t*)(ws + WS_VT);
    const float* rowb = (const float*)(ws + WS_ROWB); const float* colb = (const float*)(ws + WS_COLB); const float* cmaxt = (const float*)(ws + WS_CMAXT);
    bf16_t* CAT = (bf16_t*)(ws + WS_CAT);
    if (bh < 32) { const int b = bh >> 3, h = bh & 7; const size_t tok0 = (size_t)b * SEQ;
        attn_unit<0>(lds, P + tok0 * LDP + 2048 + h * 128, P + tok0 * LDP + 3072 + h * 128, LDP, VT + (size_t)(512 + h * 128) * M + tok0,
                     rowb + (size_t)(b * 12 + 4 + h) * SEQ, colb + (size_t)(b * 12 + 4 + h) * SEQ, nullptr, CAT + tok0 * D + 1024 + h * 128, nullptr, nullptr, qb,
                     __uint_as_float(((const unsigned*)(ws + WS_BAR))[3968 + 32 * l + b * 8 + h]));
    } else { const int b2 = (bh - 32) >> 2, h = (bh - 32) & 3; const size_t tok0 = (size_t)b2 * SEQ;
        attn_unit<1>(lds, QK + tok0 * 1024 + h * 128, QK + tok0 * 1024 + 512 + h * 128, 1024, VT + (size_t)(h * 128) * M + tok0,
                     rowb + (size_t)(b2 * 12 + h) * SEQ, colb + (size_t)(b2 * 12 + h) * SEQ, cmaxt + (size_t)(b2 * 12 + h) * 64, CAT + tok0 * D + h * 128, P + tok0 * LDP + 1024 + h * 128,
                     a.in[12] + (size_t)l * 512 + h * 128, qb, 0.f);
    }
}

__global__ void __launch_bounds__(NTHR, 2) mega_fwd(Args a) {
    extern __shared__ __attribute__((aligned(16))) unsigned char lds_raw[];
    LAS unsigned char* lds = (LAS unsigned char*)lds_raw;
    const int G = gridDim.x, NGW = G * NWAVES;
    unsigned char* ws = a.ws;
    if (threadIdx.x < 64) ((LAS unsigned*)(lds + 151552))[threadIdx.x] = 0u;
    __syncthreads();
    const XcdBarrier bar = xcd_barrier_post((unsigned*)(ws + WS_BAR), (volatile LAS unsigned*)(lds + 151552));
    bf16_t* XN = (bf16_t*)(ws + WS_XN); float* RINV = (float*)(ws + WS_RINV);
    unsigned nloc = 0u;
    for (int ph = a.ph_lo; ph < a.ph_hi; ++ph) {
        const int tid = mytid(), lane = tid & 63, wave = __builtin_amdgcn_readfirstlane(tid >> 6);
        const int gw = blockIdx.x * NWAVES + wave;
        const bool grouped = (G == 256);
        const int nm0 = grouped ? 2048 * (int)(blockIdx.x & 7) + 64 * (int)(blockIdx.x >> 3) + 8 * wave : gw, nstep = grouped ? 1 : NGW, nend = grouped ? nm0 + 8 : M;
        if (ph == 0) {
#ifndef NO_P0
            p0_weights(a, lds, gw, NGW, wave, lane);
#endif
            norm_rows<true, false, false>(a.in[0], XN, nullptr, nullptr, 0.f, RINV, nm0, nstep, nend, lane);
        } else {
            const int l = (ph - 1) / 11, s = (ph - 1) % 11;
            unsigned char* wl = ws + (size_t)l * WS_WL;
            if (s == 0 || s == 8) {
                pg8::Gemm g{XN, (const bf16_t*)(wl + (s == 0 ? W_BT1 : W_BT2)), M, 2 * FF, D}; pg8::StaticOrder S; S.init(M, 2 * FF, G, (int)blockIdx.x);
                pg8::EpiSwiglu E{(bf16_t*)(ws + WS_BIG), FF};
                pg8::gemm_phase<pg8::EpiSwiglu, pg8::StaticOrder, true, true>(lds, g, S, E);
            } else if (s == 1 || s == 9 || s == 6) {
                pg8::Gemm g{}; g.M = M; g.N = D;
                if (s == 6) { g.A = (const bf16_t*)(ws + WS_CAT); g.Bt = (const bf16_t*)(wl + W_WOUT); g.K = D; }
                else { g.A = (const bf16_t*)(ws + WS_BIG); g.Bt = (const bf16_t*)(wl + (s == 1 ? W_WD1 : W_WD2)); g.K = FF; }
                pg8::StaticOrder S; S.init(M, D, G, (int)blockIdx.x);
                pg8::EpiStore E{(bf16_t*)(ws + (s == 6 ? WS_H_MIX : WS_H_FFN)), D};
                pg8::gemm_phase<pg8::EpiStore, pg8::StaticOrder, true, true>(lds, g, S, E);
            } else if (s == 2 || s == 7 || s == 10) {
                const float* post_g = a.in[s == 2 ? 2 : (s == 7 ? 7 : 18)] + (size_t)l * D;
                const float wgt = (s == 7) ? 1.f : 0.5f;
                const bool wx = !(s == 10 && l == DEPTH - 1);
                const bf16_t* Hh = (const bf16_t*)(ws + (s == 7 ? WS_H_MIX : WS_H_FFN));
                if (wx) norm_rows<false, true, false>(XN, XN, Hh, post_g, wgt, RINV, nm0, nstep, nend, lane);
                else norm_rows<false, true, true>(XN, a.out, Hh, post_g, wgt, RINV, nm0, nstep, nend, lane);
            } else if (s == 3) {
                pg8::Gemm g{XN, (const bf16_t*)(wl + W_WIN), M, NP, D, (const bf16_t*)(wl + W_WV), XN}; pg8::DualOrder S; S.init(M, NP, NV, M, G, (int)blockIdx.x);
                pg8::EpiWinDual E{pg8::EpiWin{(bf16_t*)(ws + WS_P), LDP, (float*)(ws + WS_GATES), GATE_PN}, pg8::EpiStore{(bf16_t*)(ws + WS_VT), M}};
                pg8::gemm_phase<pg8::EpiWinDual, pg8::DualOrder, true, true>(lds, g, S, E);
            } else if (s == 4) {
#ifndef NO_PREP
                prep_phase(a, l, lds);
#endif
            } else if (s == 5) {
                { pg8::Gemm g{(const bf16_t*)(ws + WS_DPOOL), (const bf16_t*)(wl + W_WPOOL), M, 512, 512}; pg8::StaticOrder S; S.init(M, 512, G, (int)blockIdx.x);
                  pg8::EpiPool E{(bf16_t*)(ws + WS_CAT) + 512, D, a.in[14] + (size_t)l * 512};
                  pg8::gemm_phase<pg8::EpiPool, pg8::StaticOrder, true, true>(lds, g, S, E); }
                __syncthreads();
#ifndef NO_ATTN
                {
                    unsigned* ctr = (unsigned*)(ws + WS_BAR) + 3840 + 64 * l;
                    volatile LAS unsigned* nxt = (volatile LAS unsigned*)(lds + 151552 + 256);
                    for (;;) {
                        if (tid == 0) *nxt = __hip_atomic_fetch_add(ctr, 1u, __ATOMIC_RELAXED, __HIP_MEMORY_SCOPE_AGENT);
                        __syncthreads();
                        const int u = (int)*nxt;
                        __syncthreads();
                        if (u >= 48 * 16) break;
                        attn_dispatch(a, l, lds, u % 48, 15 - u / 48);
                    }
                }
#endif
            }
        }
        if (ph + 1 < a.ph_hi) {
            const int sq = (ph - 1) % 11;
            const bool local = grouped && ph > 0 && (sq == 0 || sq == 1 || sq == 6 || sq == 7 || sq == 8 || sq == 9 || sq == 10);
            if (ph == 0) cg::this_grid().sync();
            else if (local) { nloc += 32u; grp_barrier((unsigned*)(ws + WS_BAR) + 3584 + 16 * (blockIdx.x & 7), nloc); }
            else xcd_barrier(bar);
        }
    }
}

extern "C" void kernel_launch(void* const* d_in, const int* in_sizes, int n_in, void* d_out, int out_size, void* d_ws, size_t ws_size, hipStream_t stream) {
    static int grid = 0;
    if (grid == 0) {
        if (n_in != 22 || out_size != M * D || ws_size < WS_END) { fprintf(stderr, "kernel_launch: unexpected shapes (n_in %d out %d ws %zu need %zu)\n", n_in, out_size, ws_size, (size_t)WS_END); grid = -1; return; }
        int dev = 0, cus = 0, per_cu = 0;
        hipGetDevice(&dev); hipDeviceGetAttribute(&cus, hipDeviceAttributeMultiprocessorCount, dev);
        if (hipFuncSetAttribute((const void*)mega_fwd, hipFuncAttributeMaxDynamicSharedMemorySize, LDS_BYTES) != hipSuccess) { fprintf(stderr, "kernel_launch: hipFuncSetAttribute failed\n"); grid = -1; return; }
        if (hipOccupancyMaxActiveBlocksPerMultiprocessor(&per_cu, (const void*)mega_fwd, NTHR, LDS_BYTES) != hipSuccess || per_cu < 1) per_cu = 1;
        (void)hipGetLastError();
        grid = cus * per_cu;
        if (grid > cus) grid = cus;
    }
    if (grid < 0) return;
    if (hipMemsetAsync((char*)d_ws + WS_BAR, 0, BAR_BYTES, stream) != hipSuccess) { fprintf(stderr, "kernel_launch: memset failed\n"); return; }
    Args a{};
    for (int i = 0; i < 22; ++i) a.in[i] = (const float*)d_in[i];
    a.out = (float*)d_out; a.ws = (unsigned char*)d_ws;
#if MK_COOP
    a.ph_lo = 0; a.ph_hi = NPHASE;
    void* kargs[] = {&a};
    hipError_t e = hipLaunchCooperativeKernel((const void*)mega_fwd, dim3(grid), dim3(NTHR), kargs, LDS_BYTES, stream);
    if (e != hipSuccess) fprintf(stderr, "cooperative launch failed: %s (grid %d)\n", hipGetErrorString(e), grid);
#else
    for (int ph = 0; ph < NPHASE; ++ph) {
        a.ph_lo = ph; a.ph_hi = ph + 1;
        hipLaunchKernelGGL(mega_fwd, dim3(grid), dim3(NTHR), LDS_BYTES, stream, a);
    }
#endif
}
```

```cpp
#include <hip/hip_runtime.h>
#include <hip/hip_cooperative_groups.h>
#include <cstdio>
#include <cstdint>
namespace cg = cooperative_groups;

#ifndef MK_COOP
#define MK_COOP 1
#endif

__device__ __forceinline__ int mytid() { int t = threadIdx.x; asm volatile("" : "+v"(t)); return t; }
namespace pg8 {
#define PG8_LAS __attribute__((address_space(3)))
typedef unsigned short bf16_t;
typedef short bf16x8 __attribute__((ext_vector_type(8)));
typedef float f32x4 __attribute__((ext_vector_type(4)));
typedef unsigned u32x4 __attribute__((ext_vector_type(4)));
constexpr int BM = 256, BK = 64, HALF = 128, HTB = HALF * BK * 2  , STAGE_BYTES = 8 * HTB, NXCD = 8, WGM = 8;

__host__ __device__ __forceinline__ int lds_byte(int r, int c) { const int st = (r >> 4) * 2 + (c >> 5), rr = r & 15, cc = c & 31, ob = rr * 64 + cc * 2; return st * 1024 + (ob ^ (((ob >> 9) & 1) << 5)); }
__host__ __device__ __forceinline__ void stage_rc(int b, int& R, int& C) { const int st = b / 1024, sb = b % 1024, swz = sb ^ (((sb >> 9) & 1) << 5); R = (st >> 1) * 16 + swz / 64; C = (st & 1) * 32 + (swz % 64) / 2; }
__host__ __device__ __forceinline__ int perm32(int rho) { const int n = rho >> 4, i = rho & 15; return 8 * (i >> 2) + 4 * n + (i & 3); }

struct Unit { int pm, pn, job; };
struct Gemm { const bf16_t* A; const bf16_t* Bt; int M, N, K; const bf16_t* A2; const bf16_t* Bt2; };

struct StaticOrder {
    int nM, nN, nwg, G, c;
    __host__ __device__ void init(int M, int N, int G_, int c_) { nM = M / BM; nN = N / BM; nwg = nM * nN; G = G_; c = c_; }
    __host__ __device__ void map(long L, Unit& u) const {
        int wgid = (int)L; { const int q = nwg / NXCD, r = nwg % NXCD, xcd = wgid % NXCD, off = wgid / NXCD; wgid = (xcd < r ? xcd * (q + 1) : r * (q + 1) + (xcd - r) * q) + off; }
        const int nig = WGM * nN, gid = wgid / nig, fm = gid * WGM, gsz = (nM - fm) < WGM ? (nM - fm) : WGM;
        u.pm = fm + ((wgid % nig) % gsz); u.pn = (wgid % nig) / gsz; u.job = 0;
    }
    __host__ __device__ bool next(int i, Unit& u) const {
        const long L = (long)i * G + c; if (L >= nwg) return false;
        map(L, u); return true;
    }
    __device__ __forceinline__ void a_ready(const Unit&) const {}
    __device__ __forceinline__ void done(const Unit&) const {}
};

struct DualOrder {
    StaticOrder o1, o2;
    __host__ __device__ void init(int M1, int N1, int M2, int N2, int G_, int c_) { o1.init(M1, N1, G_, c_); o2.init(M2, N2, G_, c_); }
    __host__ __device__ bool next(int i, Unit& u) const {
        const long L = (long)i * o1.G + o1.c;
        if (L < o1.nwg) { o1.map(L, u); return true; }
        if (L - o1.nwg >= o2.nwg) return false;
        o2.map(L - o1.nwg, u); u.job = 1; return true;
    }
    __device__ __forceinline__ void a_ready(const Unit&) const {}
    __device__ __forceinline__ void done(const Unit&) const {}
};
__device__ __forceinline__ unsigned cvt_pk_bf16(float lo, float hi) { unsigned r; asm volatile("v_cvt_pk_bf16_f32 %0, %1, %2" : "=v"(r) : "v"(lo), "v"(hi)); return r; }

struct EpiStore {
    static constexpr bool PERM = true, AFTER_DRAIN = false;
    bf16_t* O; int ldc;
    __device__ __forceinline__ void operator()(const f32x4 (&acc)[2][2][4][2], const Unit& u, int wr, int wc, int fr, int fq) const {
        const int row0 = u.pm * BM + wr * 64 + fr, col0 = u.pn * BM + wc * 32 + 8 * fq;
#pragma unroll
        for (int ai = 0; ai < 2; ++ai)
#pragma unroll
            for (int m = 0; m < 4; ++m) { bf16_t* rowp = O + (size_t)(row0 + ai * HALF + m * 16) * ldc + col0;
#pragma unroll
                for (int bj = 0; bj < 2; ++bj) { const f32x4 v0 = acc[ai][bj][m][0], v1 = acc[ai][bj][m][1];
                    u32x4 w; w.x = cvt_pk_bf16(v0[0], v0[1]); w.y = cvt_pk_bf16(v0[2], v0[3]); w.z = cvt_pk_bf16(v1[0], v1[1]); w.w = cvt_pk_bf16(v1[2], v1[3]);
                    *(u32x4*)(rowp + bj * HALF) = w; } }
    }
};
__device__ __forceinline__ float silu_mul(float g, float u) { return g * __builtin_amdgcn_rcpf(1.f + __builtin_amdgcn_exp2f(-1.4426950408889634f * g)) * u; }
struct EpiSwiglu {
    static constexpr bool PERM = true, AFTER_DRAIN = false;
    bf16_t* O; int ldc;
    __device__ __forceinline__ void operator()(const f32x4 (&acc)[2][2][4][2], const Unit& u, int wr, int wc, int fr, int fq) const {
        const int row0 = u.pm * BM + wr * 64 + fr, col0 = u.pn * HALF + wc * 32 + 8 * fq;
#pragma unroll
        for (int ai = 0; ai < 2; ++ai)
#pragma unroll
            for (int m = 0; m < 4; ++m) { bf16_t* rowp = O + (size_t)(row0 + ai * HALF + m * 16) * ldc + col0;
                const f32x4 g0 = acc[ai][0][m][0], g1 = acc[ai][0][m][1], u0 = acc[ai][1][m][0], u1 = acc[ai][1][m][1];
                u32x4 w; w.x = cvt_pk_bf16(silu_mul(g0[0], u0[0]), silu_mul(g0[1], u0[1])); w.y = cvt_pk_bf16(silu_mul(g0[2], u0[2]), silu_mul(g0[3], u0[3]));
                w.z = cvt_pk_bf16(silu_mul(g1[0], u1[0]), silu_mul(g1[1], u1[1])); w.w = cvt_pk_bf16(silu_mul(g1[2], u1[2]), silu_mul(g1[3], u1[3]));
                *(u32x4*)rowp = w; }
    }
};
struct EpiWin {
    static constexpr bool PERM = true, AFTER_DRAIN = false;
    bf16_t* O; int ldc; float* G; int gate_pn;
    __device__ __forceinline__ void operator()(const f32x4 (&acc)[2][2][4][2], const Unit& u, int wr, int wc, int fr, int fq) const {
        const int row0 = u.pm * BM + wr * 64 + fr, col0 = u.pn * BM + wc * 32 + 8 * fq;
        if (u.pn < gate_pn) {
#pragma unroll
            for (int ai = 0; ai < 2; ++ai)
#pragma unroll
                for (int m = 0; m < 4; ++m) { bf16_t* rowp = O + (size_t)(row0 + ai * HALF + m * 16) * ldc + col0;
#pragma unroll
                    for (int bj = 0; bj < 2; ++bj) { const f32x4 v0 = acc[ai][bj][m][0], v1 = acc[ai][bj][m][1];
                        u32x4 w; w.x = cvt_pk_bf16(v0[0], v0[1]); w.y = cvt_pk_bf16(v0[2], v0[3]); w.z = cvt_pk_bf16(v1[0], v1[1]); w.w = cvt_pk_bf16(v1[2], v1[3]);
                        *(u32x4*)(rowp + bj * HALF) = w; } }
        } else if (wc == 0 && fq < 2) {
#pragma unroll
            for (int ai = 0; ai < 2; ++ai)
#pragma unroll
                for (int m = 0; m < 4; ++m) { float* gp = G + (size_t)(row0 + ai * HALF + m * 16) * 16 + 8 * fq;
                    *(f32x4*)gp = acc[ai][0][m][0]; *(f32x4*)(gp + 4) = acc[ai][0][m][1]; }
        }
    }
};
struct EpiWinDual {
    static constexpr bool PERM = true, AFTER_DRAIN = false;
    EpiWin e1; EpiStore e2;
    __device__ __forceinline__ void operator()(const f32x4 (&acc)[2][2][4][2], const Unit& u, int wr, int wc, int fr, int fq) const {
        if (u.job) e2(acc, u, wr, wc, fr, fq); else e1(acc, u, wr, wc, fr, fq);
    }
};
struct EpiPool {
    static constexpr bool PERM = true, AFTER_DRAIN = false;
    bf16_t* O; int ldc; const float* scale;
    __device__ __forceinline__ void operator()(const f32x4 (&acc)[2][2][4][2], const Unit& u, int wr, int wc, int fr, int fq) const {
        const int row0 = u.pm * BM + wr * 64 + fr, col0 = u.pn * BM + wc * 32 + 8 * fq;
#pragma unroll
        for (int ai = 0; ai < 2; ++ai)
#pragma unroll
            for (int m = 0; m < 4; ++m) { bf16_t* rowp = O + (size_t)(row0 + ai * HALF + m * 16) * ldc + col0;
#pragma unroll
                for (int bj = 0; bj < 2; ++bj) { const f32x4 s0 = *(const f32x4*)(scale + col0 + bj * HALF), s1 = *(const f32x4*)(scale + col0 + bj * HALF + 4);
                    const f32x4 v0 = acc[ai][bj][m][0] * s0, v1 = acc[ai][bj][m][1] * s1;
                    u32x4 w; w.x = cvt_pk_bf16(v0[0], v0[1]); w.y = cvt_pk_bf16(v0[2], v0[3]); w.z = cvt_pk_bf16(v1[0], v1[1]); w.w = cvt_pk_bf16(v1[2], v1[3]);
                    *(u32x4*)(rowp + bj * HALF) = w; } }
    }
};


template <class Epi, class Sched, bool ALIGN_EPI = false, bool SP2 = false>
__device__ __forceinline__ void gemm_phase(PG8_LAS unsigned char* lds, const Gemm g, const Sched& S, const Epi& E) {
    const int tid = mytid(), wid = __builtin_amdgcn_readfirstlane(tid >> 6), lane = tid & 63, wr = wid >> 2, wc = wid & 3, fr = lane & 15, fq = lane >> 4;
    const int K = g.K, nt = K / BK;
    unsigned voffA[2], voffB[2];
#pragma unroll
    for (int i = 0; i < 2; ++i) { int R, C; stage_rc(tid * 16 + i * 8192, R, C); const int Rb = Epi::PERM ? ((R & ~31) + perm32(R & 31)) : R;
        voffA[i] = (unsigned)(R * K + C) * 2u; voffB[i] = (unsigned)(Rb * K + C) * 2u; }
    const size_t kstep = (size_t)(BK * 2);
    const size_t hstep = (size_t)HALF * K * 2;
    const size_t tstep = 2 * hstep;
    const unsigned ldsw = (unsigned)wid * 1024u;
    const int aoff = lds_byte(wr * 64 + fr, fq * 8), boff = lds_byte(wc * 32 + fr, fq * 8);
#define PG8_SA(b, h) (((b) * 2 + (h)) * HTB)
#define PG8_SB(b, h) ((4 + (b) * 2 + (h)) * HTB)
#define PG8_STAGE(bufoff, gbase, voff) do { _Pragma("unroll") for (int _i = 0; _i < 2; ++_i) \
        __builtin_amdgcn_global_load_lds((const unsigned*)((const char*)(gbase) + (voff)[_i]), (PG8_LAS unsigned*)(lds + (bufoff) + ldsw + _i * 8192), 16, 0, 0); } while (0)
#define PG8_LDA(dst, b, h) do { _Pragma("unroll") for (int m = 0; m < 4; ++m) _Pragma("unroll") for (int k = 0; k < 2; ++k) dst[m][k] = *(const PG8_LAS bf16x8*)(lds + PG8_SA(b, h) + aoff + m * 2048 + k * 1024); } while (0)
#define PG8_LDB(dst, b, h) do { _Pragma("unroll") for (int n = 0; n < 2; ++n) _Pragma("unroll") for (int k = 0; k < 2; ++k) dst[n][k] = *(const PG8_LAS bf16x8*)(lds + PG8_SB(b, h) + boff + n * 2048 + k * 1024); } while (0)
#define PG8_MMA(ai, bj, At, Bt) do { __builtin_amdgcn_s_setprio(1); _Pragma("unroll") for (int m = 0; m < 4; ++m) _Pragma("unroll") for (int n = 0; n < 2; ++n) _Pragma("unroll") for (int k = 0; k < 2; ++k) \
        acc[ai][bj][m][n] = __builtin_amdgcn_mfma_f32_16x16x32_bf16(Bt[n][k], At[m][k], acc[ai][bj][m][n], 0, 0, 0); __builtin_amdgcn_s_setprio(0); } while (0)
#define PG8_WAIT_V(n) asm volatile("s_waitcnt vmcnt(" #n ")" ::: "memory")
#define PG8_WAIT_L(n) asm volatile("s_waitcnt lgkmcnt(" #n ")" ::: "memory")
#define PG8_BAR __builtin_amdgcn_s_barrier()
#define PG8_SCHED __builtin_amdgcn_sched_barrier(0)
    Unit cur, nxt; int ui = 0;
    if (!S.next(0, cur)) return;
    f32x4 acc[2][2][4][2];
#pragma unroll
    for (int a = 0; a < 2; ++a)
#pragma unroll
        for (int b = 0; b < 2; ++b)
#pragma unroll
            for (int m = 0; m < 4; ++m)
#pragma unroll
                for (int n = 0; n < 2; ++n) acc[a][b][m][n] = (f32x4){0.f, 0.f, 0.f, 0.f};
    bf16x8 At[4][2], B0[2][2], B1[2][2];
    const char* cA = (const char*)(cur.job ? g.A2 : g.A) + (size_t)cur.pm * tstep; const char* cB = (const char*)(cur.job ? g.Bt2 : g.Bt) + (size_t)cur.pn * tstep;
    S.a_ready(cur);
    if constexpr (SP2) {
        PG8_STAGE(PG8_SB(0, 0), cB, voffB); PG8_STAGE(PG8_SB(0, 1), cB + hstep, voffB); PG8_STAGE(PG8_SA(0, 0), cA, voffA); PG8_STAGE(PG8_SA(0, 1), cA + hstep, voffA);
        if (wr == 1) PG8_BAR;
        PG8_WAIT_V(2); PG8_BAR;
        PG8_STAGE(PG8_SB(1, 0), cB + kstep, voffB); PG8_STAGE(PG8_SA(1, 0), cA + kstep, voffA); PG8_STAGE(PG8_SB(1, 1), cB + hstep + kstep, voffB);
        PG8_WAIT_V(6); PG8_BAR;
    } else {
        PG8_STAGE(PG8_SB(0, 0), cB, voffB); PG8_STAGE(PG8_SA(0, 0), cA, voffA); PG8_STAGE(PG8_SB(0, 1), cB + hstep, voffB); PG8_STAGE(PG8_SA(0, 1), cA + hstep, voffA);
        if (wr == 1) PG8_BAR;
        PG8_WAIT_V(4); PG8_BAR;
        PG8_STAGE(PG8_SB(1, 0), cB + kstep, voffB); PG8_STAGE(PG8_SA(1, 0), cA + kstep, voffA); PG8_STAGE(PG8_SB(1, 1), cB + hstep + kstep, voffB);
        PG8_WAIT_V(6); PG8_BAR;
    }
    for (;;) {
        const bool has_next = S.next(ui + 1, nxt);
        const char* nA = has_next ? (const char*)(nxt.job ? g.A2 : g.A) + (size_t)nxt.pm * tstep : cA; const char* nB = has_next ? (const char*)(nxt.job ? g.Bt2 : g.Bt) + (size_t)nxt.pn * tstep : cB;
        for (int t = 0; t < nt; t += 2) {
            const bool last = (t == nt - 2);
            const char* a1 = cA + (size_t)(t + 1) * kstep;
            const char* a2 = last ? nA : cA + (size_t)(t + 2) * kstep; const char* b2 = last ? nB : cB + (size_t)(t + 2) * kstep;
            const char* a3 = a2 + kstep; const char* b3 = b2 + kstep;
            if (last && has_next) S.a_ready(nxt);
            if constexpr (SP2) {
            PG8_LDB(B0, 0, 0); PG8_LDB(B1, 0, 1); PG8_SCHED; PG8_LDA(At, 0, 0); PG8_STAGE(PG8_SA(1, 1), a1 + hstep, voffA);
            PG8_WAIT_V(8); PG8_WAIT_L(0); PG8_BAR; PG8_MMA(0, 0, At, B0); PG8_MMA(0, 1, At, B1); PG8_BAR; PG8_SCHED;
            PG8_LDA(At, 0, 1); PG8_STAGE(PG8_SB(0, 0), b2, voffB); PG8_STAGE(PG8_SB(0, 1), b2 + hstep, voffB); PG8_STAGE(PG8_SA(0, 0), a2, voffA);
            PG8_WAIT_V(8); PG8_WAIT_L(0); PG8_BAR; PG8_MMA(1, 0, At, B0); PG8_MMA(1, 1, At, B1); PG8_BAR; PG8_SCHED;
            PG8_LDB(B0, 1, 0); PG8_LDB(B1, 1, 1); PG8_SCHED; PG8_LDA(At, 1, 0); PG8_STAGE(PG8_SA(0, 1), a2 + hstep, voffA);
            PG8_WAIT_V(8); PG8_WAIT_L(0); PG8_BAR; PG8_MMA(0, 0, At, B0); PG8_MMA(0, 1, At, B1); PG8_BAR; PG8_SCHED;
            PG8_LDA(At, 1, 1); PG8_STAGE(PG8_SB(1, 0), b3, voffB); PG8_STAGE(PG8_SB(1, 1), b3 + hstep, voffB); PG8_STAGE(PG8_SA(1, 0), a3, voffA);
            PG8_WAIT_V(8); PG8_WAIT_L(0); PG8_BAR; PG8_MMA(1, 0, At, B0); PG8_MMA(1, 1, At, B1); PG8_BAR; PG8_SCHED;
            } else {
            PG8_LDB(B0, 0, 0); PG8_SCHED; PG8_LDA(At, 0, 0); PG8_STAGE(PG8_SA(1, 1), a1 + hstep, voffA);
            PG8_WAIT_L(8); PG8_BAR; PG8_WAIT_L(0); PG8_MMA(0, 0, At, B0); PG8_BAR; PG8_SCHED;
            PG8_LDB(B1, 0, 1); PG8_STAGE(PG8_SB(0, 0), b2, voffB);
            PG8_BAR; PG8_WAIT_L(0); PG8_MMA(0, 1, At, B1); PG8_BAR;
            PG8_LDA(At, 0, 1); PG8_STAGE(PG8_SA(0, 0), a2, voffA);
            PG8_BAR; PG8_WAIT_L(0); PG8_MMA(1, 0, At, B0); PG8_BAR; PG8_SCHED;
            PG8_STAGE(PG8_SB(0, 1), b2 + hstep, voffB);
            PG8_WAIT_V(6); PG8_BAR; PG8_MMA(1, 1, At, B1); PG8_BAR;
            PG8_LDB(B0, 1, 0); PG8_SCHED; PG8_LDA(At, 1, 0); PG8_STAGE(PG8_SA(0, 1), a2 + hstep, voffA);
            PG8_WAIT_L(8); PG8_BAR; PG8_WAIT_L(0); PG8_MMA(0, 0, At, B0); PG8_BAR; PG8_SCHED;
            PG8_LDB(B1, 1, 1); PG8_STAGE(PG8_SB(1, 0), b3, voffB);
            PG8_BAR; PG8_WAIT_L(0); PG8_MMA(0, 1, At, B1); PG8_BAR;
            PG8_LDA(At, 1, 1); PG8_STAGE(PG8_SA(1, 0), a3, voffA);
            PG8_BAR; PG8_WAIT_L(0); PG8_MMA(1, 0, At, B0); PG8_BAR; PG8_SCHED;
            PG8_STAGE(PG8_SB(1, 1), b3 + hstep, voffB);
            PG8_WAIT_V(6); PG8_BAR; PG8_MMA(1, 1, At, B1); PG8_BAR;
            }
        }
        if constexpr (ALIGN_EPI) { if (wr == 0) PG8_BAR; }
        if constexpr (!Epi::AFTER_DRAIN) { E(acc, cur, wr, wc, fr, fq); S.done(cur); }
        if (!has_next) break;
#pragma unroll
        for (int a = 0; a < 2; ++a)
#pragma unroll
            for (int b = 0; b < 2; ++b)
#pragma unroll
                for (int m = 0; m < 4; ++m)
#pragma unroll
                    for (int n = 0; n < 2; ++n) acc[a][b][m][n] = (f32x4){0.f, 0.f, 0.f, 0.f};
        cur = nxt; cA = nA; cB = nB; ++ui;
        if constexpr (ALIGN_EPI) { if (wr == 1) PG8_BAR; }
    }
    PG8_WAIT_V(0);
    if constexpr (!ALIGN_EPI) { if (wr == 0) PG8_BAR; }
    PG8_BAR;
    if constexpr (Epi::AFTER_DRAIN) { E.fused(acc, cur, wr, wc, fr, fq, lds, wid, lane); S.done(cur); }
#undef PG8_SA
#undef PG8_SB
#undef PG8_STAGE
#undef PG8_LDA
#undef PG8_LDB
#undef PG8_MMA
#undef PG8_WAIT_V
#undef PG8_WAIT_L
#undef PG8_BAR
#undef PG8_SCHED
}}

#define LAS __attribute__((address_space(3)))
typedef unsigned short bf16_t;
typedef short bf16x8 __attribute__((ext_vector_type(8)));
typedef short s16x4 __attribute__((ext_vector_type(4)));
typedef float f32x4 __attribute__((ext_vector_type(4)));
typedef float f32x16 __attribute__((ext_vector_type(16)));
typedef unsigned u32x4 __attribute__((ext_vector_type(4)));
typedef unsigned u32x2 __attribute__((ext_vector_type(2)));
typedef float f32x2_t __attribute__((ext_vector_type(2)));
typedef __bf16 bf16x2_t __attribute__((ext_vector_type(2)));

constexpr int NB = 4, SEQ = 4096, M = NB * SEQ, D = 2048, FF = 5632, NIN = 5648, DEPTH = 2;
constexpr int NP = 4352, LDP = 4096, GATE_PN = 16, NV = 1536;
constexpr float EPS = 1e-6f, LOG2E = 1.4426950408889634f, QSCALE = 0.08838834764831845f;
constexpr int NWAVES = 8, NTHR = 512;
constexpr int LDS_BYTES = 155648;
constexpr int NPHASE = 1 + 11 * DEPTH;

constexpr size_t MiB = 1u << 20;
constexpr size_t WS_WL = 164 * MiB;
constexpr size_t W_BT1 = 0, W_WD1 = 44 * MiB, W_BT2 = 66 * MiB, W_WD2 = 110 * MiB, W_WIN = 132 * MiB, W_WV = 149 * MiB, W_WOUT = 155 * MiB, W_WPOOL = 163 * MiB;
constexpr size_t WS_XN = 328 * MiB, WS_XB = 392 * MiB  , WS_GATES = 456 * MiB, WS_ROWB = 457 * MiB, WS_COLB = 458 * MiB;
constexpr size_t WS_CMAXT = 457 * MiB + 768 * 1024;
constexpr size_t WS_RINV = 458 * MiB + 768 * 1024;
constexpr size_t WS_BAR = 459 * MiB, BAR_BYTES = 16384;
constexpr size_t WS_BIG = 460 * MiB;
constexpr size_t WS_P = WS_BIG, WS_VT = WS_BIG + 128 * MiB, WS_QK = WS_BIG + 176 * MiB, WS_DPOOL = WS_BIG + 208 * MiB, WS_CAT = WS_BIG + 224 * MiB;
constexpr size_t WS_END = WS_BIG + 288 * MiB;
constexpr size_t WS_H_FFN = WS_BIG + 176 * MiB, WS_H_MIX = WS_BIG;

__device__ __forceinline__ unsigned f2bf(float f) { unsigned u = __builtin_bit_cast(unsigned, f); return (u + 0x7fffu + ((u >> 16) & 1u)) >> 16; }
__device__ __forceinline__ unsigned pk2(float lo, float hi) { return f2bf(lo) | (f2bf(hi) << 16); }
__device__ __forceinline__ unsigned cvtpk(float lo, float hi) { f32x2_t v = {lo, hi}; bf16x2_t b = __builtin_convertvector(v, bf16x2_t); return __builtin_bit_cast(unsigned, b); }
__device__ __forceinline__ float bflo(unsigned w) { return __builtin_bit_cast(float, w << 16); }
__device__ __forceinline__ float bfhi(unsigned w) { return __builtin_bit_cast(float, w & 0xffff0000u); }
#define LDS_WAIT() asm volatile("s_waitcnt lgkmcnt(0)" ::: "memory")
__device__ __forceinline__ float wave_sum(float v) {
#pragma unroll
    for (int o = 1; o < 64; o <<= 1) v += __shfl_xor(v, o);
    return v;
}

typedef __attribute__((address_space(1))) unsigned gu32;
#define XB_TMO      128
#define XB_XCNT(j)  (256  + 64 * (j))
#define XB_XSUB(j)  (1280 + 64 * (j))
#define XB_XGEN(j)  (2304 + 64 * (j))
#define XB_TOP      3328
#define XB_TOPGEN   3392
#define XCD_BAR_WORDS 3456
#define XB_SPIN_CAP (1u << 18)

__device__ __forceinline__ unsigned xb_ld(unsigned* p)              { return __hip_atomic_load(p, __ATOMIC_RELAXED, __HIP_MEMORY_SCOPE_AGENT); }
__device__ __forceinline__ unsigned xb_add(unsigned* p, unsigned v) { return __hip_atomic_fetch_add(p, v, __ATOMIC_RELAXED, __HIP_MEMORY_SCOPE_AGENT); }
__device__ __forceinline__ unsigned xb_xcc_id() { return (unsigned)__builtin_amdgcn_s_getreg((3 << 11) | 20) & 0xFu; }
#define XB_SPIN(cond, bar) do { unsigned _sp = 0; while (cond) { __builtin_amdgcn_s_sleep(1); \
    if ((++_sp & 255u) == 0u) { if (xb_ld(&(bar)[XB_TMO])) break; if (_sp > XB_SPIN_CAP) { atomicAdd(&(bar)[XB_TMO], 1u); break; } } } } while (0)

struct XcdBarrier {
    unsigned* bar; unsigned x;
    volatile LAS unsigned* st;
};

__device__ __forceinline__ XcdBarrier xcd_barrier_post(unsigned* bar, volatile LAS unsigned* st) {
    XcdBarrier b; b.bar = bar; b.x = xb_xcc_id(); b.st = st;
    if (threadIdx.x == 0) (void)xb_add(&bar[XB_XCNT(b.x)], 1u);
    return b;
}
__device__ __forceinline__ void xcd_barrier_complete(unsigned* bar, unsigned x, unsigned& nloc, unsigned& nx) {
    const unsigned G = gridDim.x * gridDim.y * gridDim.z;
    unsigned sum, cnt, mine, sp = 0u;
    for (;;) {
        sum = 0u; cnt = 0u; mine = 0u;
#pragma unroll
        for (unsigned j = 0; j < 16; ++j) { const unsigned c = xb_ld(&bar[XB_XCNT(j)]); sum += c; cnt += (c > 0u) ? 1u : 0u; mine = (j == x) ? c : mine; }
        if (sum == G) break;
        __builtin_amdgcn_s_sleep(1);
        if ((++sp & 255u) == 0u) { if (xb_ld(&bar[XB_TMO])) break; if (sp > XB_SPIN_CAP) { atomicAdd(&bar[XB_TMO], 1u); break; } }
    }
    nloc = mine > 0u ? mine : 1u; nx = cnt > 0u ? cnt : 1u;
}

__device__ __forceinline__ void xcd_barrier(const XcdBarrier& b) {
    asm volatile("s_waitcnt vmcnt(0)" ::: "memory");
    __syncthreads();
    if (threadIdx.x == 0) {
        unsigned* bar = b.bar;
        __builtin_amdgcn_s_waitcnt(0);
        unsigned nloc = b.st[0], nx = b.st[1];
        if (nloc == 0u) { xcd_barrier_complete(bar, b.x, nloc, nx); b.st[0] = nloc; b.st[1] = nx; }
        const unsigned old = xb_add(&bar[XB_XSUB(b.x)], 1u);
        const unsigned gen = old / nloc;
        if (old + 1u == (gen + 1u) * nloc) {
            __builtin_amdgcn_fence(__ATOMIC_RELEASE, "agent");
            asm volatile("s_waitcnt vmcnt(0)" ::: "memory");
            const unsigned og = xb_add(&bar[XB_TOP], 1u);
            const unsigned tg = og / nx;
            if (og + 1u == (tg + 1u) * nx) xb_add(&bar[XB_TOPGEN], 1u);
            else XB_SPIN(xb_ld(&bar[XB_TOPGEN]) == tg, bar);
            __builtin_amdgcn_fence(__ATOMIC_ACQUIRE, "agent");
            xb_add(&bar[XB_XGEN(b.x)], 1u);
            asm volatile("s_waitcnt vmcnt(0)" ::: "memory");
        } else {
            XB_SPIN(xb_ld(&bar[XB_XGEN(b.x)]) == gen, bar);
            __builtin_amdgcn_fence(__ATOMIC_ACQUIRE, "agent");
            asm volatile("s_waitcnt vmcnt(0)" ::: "memory");
        }
    }
    __syncthreads();
}

struct Args { const float* in[22]; float* out; unsigned char* ws; int ph_lo, ph_hi; };

struct P0Item { const float* src; size_t ld, Kd; int k0, c0, r0; bf16_t* dst; const float* gk; };
struct P0Regs { float v[32]; float gl; };
__device__ __forceinline__ void tr_load(const P0Item& p, P0Regs& r, int lane) {
    r.gl = p.gk ? p.gk[p.k0 + lane] : 1.f;
#pragma unroll
    for (int i = 0; i < 32; ++i) { const int kk = 2 * i + (lane >> 5); r.v[i] = p.src[(size_t)(p.k0 + kk) * p.ld + p.c0 + (lane & 31)]; }
}
__device__ __forceinline__ void tr_store(const P0Item& p, const P0Regs& r, LAS float* scr, int lane) {
#pragma unroll
    for (int i = 0; i < 32; ++i) { const int kk = 2 * i + (lane >> 5); scr[kk * 33 + (lane & 31)] = r.v[i] * __shfl(r.gl, kk); }
    LDS_WAIT(); asm volatile("" ::: "memory");
    const int c = lane & 7;
#pragma unroll
    for (int j = 0; j < 4; ++j) { const int n = (lane >> 3) + 8 * j; const LAS float* s = scr + (8 * c) * 33 + n;
        u32x4 o; o.x = pk2(s[0 * 33], s[1 * 33]); o.y = pk2(s[2 * 33], s[3 * 33]); o.z = pk2(s[4 * 33], s[5 * 33]); o.w = pk2(s[6 * 33], s[7 * 33]);
        *(u32x4*)(p.dst + (size_t)(p.r0 + n) * p.Kd + p.k0 + 8 * c) = o; }
    LDS_WAIT(); asm volatile("" ::: "memory");
}

constexpr int IT_FF = 5632, IT_L = 6 * IT_FF + IT_FF + 2048 + 32;
__device__ __forceinline__ P0Item p0_decode(const Args& a, unsigned char* ws, int it) {
        const int l = it / IT_L; int r = it % IT_L;
        unsigned char* wl = ws + (size_t)l * WS_WL;
        const float* src; size_t ld, Kd; int k0, c0, r0; bf16_t* dst; const float* gk = nullptr;
        if (r < 6 * IT_FF) {
            const int f = r / (3 * IT_FF), r2 = r % (3 * IT_FF), mat = r2 / IT_FF, i = r2 % IT_FF;
            if (mat < 2) { const int kb = i / 176, nb = i % 176;
                src = a.in[f ? (mat ? 20 : 19) : (mat ? 4 : 3)] + (size_t)l * D * FF; ld = FF; k0 = kb * 64; c0 = nb * 32;
                dst = (bf16_t*)(wl + (f ? W_BT2 : W_BT1)); Kd = D; r0 = (nb >> 2) * 256 + (nb & 3) * 32 + mat * 128; gk = a.in[f ? 17 : 1] + (size_t)l * D;
            } else { const int kb = i / 64, nb = i % 64;
                src = a.in[f ? 21 : 5] + (size_t)l * FF * D; ld = D; k0 = kb * 64; c0 = nb * 32;
                dst = (bf16_t*)(wl + (f ? W_WD2 : W_WD1)); Kd = FF; r0 = nb * 32; }
        } else if (r < 7 * IT_FF) {
            const int i = r - 6 * IT_FF, kb = i / 176, j = i % 176;
            src = a.in[8] + (size_t)l * D * NIN; ld = NIN; k0 = kb * 64; Kd = D; gk = a.in[6] + (size_t)l * D;
            if (j < 128) { dst = (bf16_t*)(wl + W_WIN); r0 = j * 32;
                if (j < 32) c0 = j * 32;
                else if (j < 48) c0 = 1536 + (j - 32) * 32;
                else if (j < 64) c0 = 2056 + (j - 48) * 32;
                else if (j < 96) c0 = 2568 + (j - 64) * 32;
                else c0 = 3592 + (j - 96) * 32;
            } else { dst = (bf16_t*)(wl + W_WV);
                if (j < 144) { r0 = (j - 128) * 32; c0 = 1024 + (j - 128) * 32; }
                else { r0 = 512 + (j - 144) * 32; c0 = 4616 + (j - 144) * 32; } }
        } else if (r < 7 * IT_FF + 2048) {
            const int i = r - 7 * IT_FF, kb = i / 64, nb = i % 64;
            src = a.in[16] + (size_t)l * D * D; ld = D; k0 = kb * 64; c0 = nb * 32; dst = (bf16_t*)(wl + W_WOUT); Kd = D; r0 = nb * 32;
        } else {
            const int i = r - 7 * IT_FF - 2048, g = i >> 3, kb = (i >> 2) & 1, nb = i & 3;
            src = a.in[13] + (size_t)(l * 4 + g) * 128 * 128; ld = 128; k0 = kb * 64; c0 = nb * 32; dst = (bf16_t*)(wl + W_WPOOL) + g * 128; Kd = 512; r0 = g * 128 + nb * 32;
        }
        P0Item p; p.src = src; p.ld = ld; p.Kd = Kd; p.k0 = k0; p.c0 = c0; p.r0 = r0; p.dst = dst; p.gk = gk; return p;
}
__device__ __forceinline__ void p0_weights(const Args& a, LAS unsigned char* lds, int gw, int NGW, int wave, int lane) {
    LAS float* scr = (LAS float*)(lds + wave * 8704);
    unsigned char* ws = a.ws;
    if (gw < DEPTH * IT_L) {
        P0Item pc = p0_decode(a, ws, gw); P0Regs rc; tr_load(pc, rc, lane);
        for (int it = gw; it < DEPTH * IT_L; it += NGW) {
            const int itn = it + NGW; const bool more = itn < DEPTH * IT_L;
            P0Item pn = pc; P0Regs rn = rc;
            if (more) { pn = p0_decode(a, ws, itn); tr_load(pn, rn, lane); }
            tr_store(pc, rc, scr, lane);
            pc = pn; rc = rn;
        }
    }
    const int gt = gw * 64 + lane, NT = NGW * 64;
    for (int idx = gt; idx < DEPTH * 256 * D; idx += NT) {
        const int l = idx / (256 * D), rr = (idx / D) & 255, k = idx % D;
        float v = 0.f;
        if (rr < 8) v = a.in[8][(size_t)l * D * NIN + (size_t)k * NIN + 2048 + rr];
        else if (rr < 16) v = a.in[8][(size_t)l * D * NIN + (size_t)k * NIN + 5640 + (rr - 8)];
        ((bf16_t*)(ws + (size_t)l * WS_WL + W_WIN))[(size_t)(4096 + rr) * D + k] = (bf16_t)f2bf(v * a.in[6][(size_t)l * D + k]);
    }
    for (int idx = gt; idx < DEPTH * 512 * 512; idx += NT) {
        const int l = idx / (512 * 512), rr = (idx >> 9) & 511, c = idx & 511;
        if ((rr >> 7) != (c >> 7)) ((bf16_t*)(ws + (size_t)l * WS_WL + W_WPOOL))[rr * 512 + c] = 0;
    }
}

template <bool IN_F32, bool HAS_H, bool OUT_F32>
__device__ __forceinline__ void norm_rows(const void* xin, void* xout, const bf16_t* h, const float* post_g, float wgt, float* rinv, int gw, int NGW, int lane) {
    int m = gw; if (m >= M) return;
    f32x4 nvf[IN_F32 ? 8 : 1]; u32x2 nvb[IN_F32 ? 1 : 8]; u32x2 nh[HAS_H ? 8 : 1]; float nri = 1.f;
#define NR_LOAD(mm) do { if (IN_F32) { const f32x4* xr = (const f32x4*)((const float*)xin + (size_t)(mm) * D) + lane; _Pragma("unroll") for (int j = 0; j < 8; ++j) nvf[IN_F32 ? j : 0] = xr[64 * j]; } \
        else { const u32x2* xr = (const u32x2*)((const bf16_t*)xin + (size_t)(mm) * D) + lane; _Pragma("unroll") for (int j = 0; j < 8; ++j) nvb[IN_F32 ? 0 : j] = xr[64 * j]; nri = rinv[mm]; } \
        if (HAS_H) { const u32x2* hr = (const u32x2*)(h + (size_t)(mm) * D) + lane; _Pragma("unroll") for (int j = 0; j < 8; ++j) nh[HAS_H ? j : 0] = hr[64 * j]; } } while (0)
    NR_LOAD(m);
    for (; m < M; m += NGW) {
        f32x4 v[8]; u32x2 hw[8];
        const float ri = nri;
#pragma unroll
        for (int j = 0; j < 8; ++j) {
            if (IN_F32) v[j] = nvf[IN_F32 ? j : 0]; else { const u32x2 w = nvb[IN_F32 ? 0 : j]; v[j] = (f32x4){bflo(w.x), bfhi(w.x), bflo(w.y), bfhi(w.y)} * ri; }
            if (HAS_H) hw[j] = nh[HAS_H ? j : 0]; }
        const int mn = m + NGW;
        if (mn < M) NR_LOAD(mn);
        if (HAS_H) {
            f32x4 hv[8]; float s = 0.f;
#pragma unroll
            for (int j = 0; j < 8; ++j) { const u32x2 w = hw[j]; hv[j] = (f32x4){bflo(w.x), bfhi(w.x), bflo(w.y), bfhi(w.y)};
                s += (hv[j][0] * hv[j][0] + hv[j][1] * hv[j][1]) + (hv[j][2] * hv[j][2] + hv[j][3] * hv[j][3]); }
            const float r = rsqrtf(wave_sum(s) * (1.f / D) + EPS) * wgt;
#pragma unroll
            for (int j = 0; j < 8; ++j) { const f32x4 g = ((const f32x4*)post_g)[64 * j + lane]; v[j] = v[j] + hv[j] * r * g; }
        }
        if (OUT_F32) { f32x4* xo = (f32x4*)((float*)xout + (size_t)m * D) + lane;
#pragma unroll
            for (int j = 0; j < 8; ++j) xo[64 * j] = v[j];
        } else {
            float s2 = 0.f;
#pragma unroll
            for (int j = 0; j < 8; ++j) s2 += (v[j][0] * v[j][0] + v[j][1] * v[j][1]) + (v[j][2] * v[j][2] + v[j][3] * v[j][3]);
            const float ms = wave_sum(s2) * (1.f / D) + EPS, r2 = rsqrtf(ms);
            if (lane == 0) rinv[m] = sqrtf(ms);
            u32x2* o8 = (u32x2*)((bf16_t*)xout + (size_t)m * D) + lane;
#pragma unroll
            for (int j = 0; j < 8; ++j) { const f32x4 y = v[j] * r2; u32x2 w; w.x = pk2(y[0], y[1]); w.y = pk2(y[2], y[3]); o8[64 * j] = w; }
        }
    }
#undef NR_LOAD
}

__device__ __forceinline__ void unpack8(const u32x4 w, float* f) { f[0] = bflo(w.x); f[1] = bfhi(w.x); f[2] = bflo(w.y); f[3] = bfhi(w.y); f[4] = bflo(w.z); f[5] = bfhi(w.z); f[6] = bflo(w.w); f[7] = bfhi(w.w); }
__device__ __forceinline__ float logsig(float x) { return fminf(x, 0.f) - log1pf(expf(-fabsf(x))); }
__device__ __forceinline__ void prep_phase(const Args& a, int l, LAS unsigned char* lds) {
    unsigned char* ws = a.ws;
    const bf16_t* P = (const bf16_t*)(ws + WS_P);
    bf16_t* QK = (bf16_t*)(ws + WS_QK); bf16_t* DP = (bf16_t*)(ws + WS_DPOOL);
    const float* conv = a.in[9] + (size_t)l * 4 * 1024;
    const int tid0 = mytid(); const int gt = blockIdx.x * NTHR + tid0, NT = gridDim.x * NTHR;
    for (int idx = gt; idx < (M / 16) * 128; idx += NT) {
        const int c8 = (idx & 127) * 8, tok0 = (idx >> 7) * 16; const bool head = ((tok0 & (SEQ - 1)) == 0);
        u32x4 rows[19];
#pragma unroll
        for (int i = 0; i < 19; ++i) { const bool valid = (i >= 3) || !head; const int r = valid ? tok0 - 3 + i : tok0;
            const u32x4 w = *(const u32x4*)(P + (size_t)r * LDP + c8); rows[i] = valid ? w : (u32x4){0u, 0u, 0u, 0u}; }
        float wj[4][8];
#pragma unroll
        for (int j = 0; j < 4; ++j) { const f32x4 w0 = *(const f32x4*)(conv + j * 1024 + c8), w1 = *(const f32x4*)(conv + j * 1024 + c8 + 4);
#pragma unroll
            for (int e = 0; e < 4; ++e) { wj[j][e] = w0[e]; wj[j][4 + e] = w1[e]; } }
#pragma unroll
        for (int tt = 0; tt < 16; ++tt) {
            float acc[8];
#pragma unroll
            for (int e = 0; e < 8; ++e) acc[e] = 0.f;
#pragma unroll
            for (int j = 0; j < 4; ++j) { float u[8]; unpack8(rows[tt + 3 - j], u);
#pragma unroll
                for (int e = 0; e < 8; ++e) acc[e] += u[e] * wj[j][e]; }
#pragma unroll
            for (int e = 0; e < 8; ++e) acc[e] = acc[e] / (1.f + __expf(-acc[e]));
            u32x4 o; o.x = pk2(acc[0], acc[1]); o.y = pk2(acc[2], acc[3]); o.z = pk2(acc[4], acc[5]); o.w = pk2(acc[6], acc[7]);
            *(u32x4*)(QK + (size_t)(tok0 + tt) * 1024 + c8) = o;
        }
    }
    for (int idx = gt; idx < M * 64; idx += NT) {
        const int ln = idx & 63, widx = idx >> 6, g = __builtin_amdgcn_readfirstlane(widx & 3), tok = (widx >> 2) * 4 + (ln >> 4), c8 = g * 128 + (ln & 15) * 8, t = tok & (SEQ - 1);
        const int win = 2 << g, n = (t + 1 < win) ? (t + 1) : win;
        float acc[8], u0[8];
        { const u32x4 w = *(const u32x4*)(P + (size_t)tok * LDP + 1536 + c8); unpack8(w, u0); }
#pragma unroll
        for (int e = 0; e < 8; ++e) acc[e] = u0[e];
#define POOL_TAPS(W) do { u32x4 rw[W - 1]; _Pragma("unroll") for (int j = 1; j < W; ++j) { const int r = (j < n) ? tok - j : tok; rw[j - 1] = *(const u32x4*)(P + (size_t)r * LDP + 1536 + c8); } \
            _Pragma("unroll") for (int j = 1; j < W; ++j) { float u[8]; unpack8(rw[j - 1], u); const float mk = (j < n) ? 1.f : 0.f; _Pragma("unroll") for (int e = 0; e < 8; ++e) acc[e] += u[e] * mk; } } while (0)
        if (g == 0) POOL_TAPS(2); else if (g == 1) POOL_TAPS(4); else if (g == 2) POOL_TAPS(8); else POOL_TAPS(16);
#undef POOL_TAPS
        const float inv = 1.f / (float)n;
#pragma unroll
        for (int e = 0; e < 8; ++e) acc[e] = acc[e] * inv - u0[e];
        u32x4 o; o.x = pk2(acc[0], acc[1]); o.y = pk2(acc[2], acc[3]); o.z = pk2(acc[4], acc[5]); o.w = pk2(acc[6], acc[7]);
        *(u32x4*)(DP + (size_t)tok * 512 + c8) = o;
    }
    {   unsigned* kn = (unsigned*)(ws + WS_BAR) + 3968 + 32 * l;
        for (int idx = gt; idx < M * 8; idx += NT) {
            const int tok = idx >> 3, h = idx & 7; const bf16_t* kp = P + (size_t)tok * LDP + 3072 + h * 128; float ss = 0.f;
#pragma unroll
            for (int c = 0; c < 16; ++c) { const u32x4 w = *(const u32x4*)(kp + c * 8); float u[8]; unpack8(w, u);
#pragma unroll
                for (int e = 0; e < 8; ++e) ss += u[e] * u[e]; }
            ss = fmaxf(ss, __shfl_xor(ss, 8)); ss = fmaxf(ss, __shfl_xor(ss, 16)); ss = fmaxf(ss, __shfl_xor(ss, 32));
            if ((tid0 & 63) < 8) atomicMax(&kn[(tok >> 12) * 8 + h], __float_as_uint(ss));
        }
    }
    if (blockIdx.x < NB * 12) {
        const int seq = blockIdx.x, b = seq / 12, hh = seq % 12, tid = tid0, lane = tid & 63, wv = tid >> 6;
        const float* G = (const float*)(ws + WS_GATES);
        float* rowb = (float*)(ws + WS_ROWB) + (size_t)seq * SEQ; float* colb = (float*)(ws + WS_COLB) + (size_t)seq * SEQ;
        const float bi = (hh < 4) ? a.in[10][l * 4 + hh] : 0.f;
        const float bf = (hh < 4) ? a.in[11][l * 4 + hh] : a.in[15][l * 8 + (hh - 4)];
        const int gi = (hh < 4) ? hh : 0, gf = (hh < 4) ? 4 + hh : 8 + (hh - 4);
        double loc[8]; float iv[8]; double run = 0.0;
#pragma unroll
        for (int e = 0; e < 8; ++e) { const float* g = G + (size_t)(b * SEQ + tid * 8 + e) * 16;
            iv[e] = g[gi] + bi; run += (double)logsig(g[gf] + bf); loc[e] = run; }
        double incl = run;
#pragma unroll
        for (int o = 1; o < 64; o <<= 1) { const double t2 = __shfl_up(incl, o); if (lane >= o) incl += t2; }
        LAS double* sh = (LAS double*)lds;
        __syncthreads();
        if (lane == 63) sh[wv] = incl;
        __syncthreads();
        double off = incl - run;
        for (int w2 = 0; w2 < wv; ++w2) off += sh[w2];
        float cb[8]; float tmax = -INFINITY;
#pragma unroll
        for (int e = 0; e < 8; ++e) { const double c = loc[e] + off; const int pos = tid * 8 + e;
            rowb[pos] = (float)(c * (double)LOG2E);
            cb[e] = (hh < 4) ? (float)(((double)iv[e] - c) * (double)LOG2E) : (float)(-c * (double)LOG2E); tmax = fmaxf(tmax, cb[e]); }
        if (hh < 4) {
            tmax = fmaxf(tmax, __shfl_xor(tmax, 1)); tmax = fmaxf(tmax, __shfl_xor(tmax, 2)); tmax = fmaxf(tmax, __shfl_xor(tmax, 4));
#pragma unroll
            for (int e = 0; e < 8; ++e) colb[tid * 8 + e] = exp2f(cb[e] - tmax);
            if ((tid & 7) == 0) ((float*)(ws + WS_CMAXT))[(size_t)seq * 64 + (tid >> 3)] = tmax;
        } else {
#pragma unroll
            for (int e = 0; e < 8; ++e) colb[tid * 8 + e] = cb[e];
        }
        __syncthreads();
    }
}

constexpr int AT_SLOT = 16384, AT_NK = 4, AT_NV = 4, AT_KOFF = 0, AT_VOFF = AT_NK * AT_SLOT, AT_COFF = AT_VOFF + AT_NV * AT_SLOT, AT_CMOFF = AT_COFF + 16384;
constexpr float AT_THR = 8.f;
#define MFMA32(a, b, c) __builtin_amdgcn_mfma_f32_32x32x16_bf16((a), (b), (c), 0, 0, 0)
#define AT_SB() __builtin_amdgcn_sched_barrier(0)

struct AttnSt { bf16x8 qf[8]; f32x16 o[4]; bf16x8 pbp[4]; float m, lsum; };

template <int MODE, bool DO_QK, bool DO_SM, bool DO_PV, bool MASK, bool DO_LD, bool LAST>
__device__ __forceinline__ void attn_body(AttnSt& st, LAS unsigned char* lds, int i, int v3, int nt, const bf16_t* __restrict__ kgp, int pitch, const bf16_t* __restrict__ vgp,
                                          float rb, unsigned kbase, unsigned vbase, int wofs, int hi, int qi, int r0) {
    if (DO_LD) {
        const int tK = nt - 1 - ((i + 3 < nt) ? i + 3 : nt - 1), tV = nt - 1 - ((i + 2 < nt) ? i + 2 : nt - 1);
        const bf16_t* gk = kgp + (size_t)(tK * 64) * pitch; const bf16_t* gv = vgp + tV * 64;
        LAS unsigned char* dk = lds + AT_KOFF + ((i + 3) & 3) * AT_SLOT + wofs; LAS unsigned char* dv = lds + AT_VOFF + ((i + 2) & 3) * AT_SLOT + wofs;
        __builtin_amdgcn_global_load_lds((const unsigned*)gk, (LAS unsigned*)dk, 16, 0, 0);
        __builtin_amdgcn_global_load_lds((const unsigned*)(gk + (size_t)32 * pitch), (LAS unsigned*)(dk + 8192), 16, 0, 0);
        __builtin_amdgcn_global_load_lds((const unsigned*)gv, (LAS unsigned*)dv, 16, 0, 0);
        __builtin_amdgcn_global_load_lds((const unsigned*)(gv + (size_t)64 * M), (LAS unsigned*)(dv + 8192), 16, 0, 0);
    }
    LAS const unsigned char* Kb = lds + AT_KOFF + (i & 3) * AT_SLOT;
    LAS const unsigned char* Vb = lds + AT_VOFF + ((i - 1) & 3) * AT_SLOT;
    const int k0 = (nt - 1 - i) * 64;
    LAS const unsigned char* Cb = lds + AT_COFF + (k0 + 8 * hi) * 4;
    f32x16 sn0, sn1;
    bf16x8 fa[4], fb[4];
#define AT_KLD(F, b) do { F[0] = *(LAS const bf16x8*)(Kb + (kbase ^ ((2 * (b)) << 5))); F[1] = *(LAS const bf16x8*)(Kb + 8192 + (kbase ^ ((2 * (b)) << 5))); \
                          F[2] = *(LAS const bf16x8*)(Kb + (kbase ^ ((2 * (b) + 1) << 5))); F[3] = *(LAS const bf16x8*)(Kb + 8192 + (kbase ^ ((2 * (b) + 1) << 5))); } while (0)
#define AT_KMM(F, b) do { sn0 = MFMA32(F[0], st.qf[2 * (b)], sn0); sn1 = MFMA32(F[1], st.qf[2 * (b)], sn1); sn0 = MFMA32(F[2], st.qf[2 * (b) + 1], sn0); sn1 = MFMA32(F[3], st.qf[2 * (b) + 1], sn1); } while (0)
#define AT_VLD(F, g) do { _Pragma("unroll") for (int d_ = 0; d_ < 4; ++d_) F[d_] = *(LAS const bf16x8*)(Vb + d_ * 4096 + (vbase ^ ((g) << 5))); } while (0)
#define AT_VMM(F, g) do { _Pragma("unroll") for (int d_ = 0; d_ < 4; ++d_) st.o[d_] = MFMA32(F[d_], st.pbp[g], st.o[d_]); } while (0)
    const bool active = !MASK || (k0 <= r0 + 31);
    if (active) {
    if (DO_QK) {
#pragma unroll
        for (int r = 0; r < 16; ++r) { sn0[r] = 0.f; sn1[r] = 0.f; }
        AT_KLD(fa, 0); AT_SB();
        AT_KLD(fb, 1); AT_KMM(fa, 0); AT_SB();
        AT_KLD(fa, 2); AT_KMM(fb, 1); AT_SB();
        AT_KLD(fb, 3); AT_KMM(fa, 2); AT_SB();
        if (DO_PV) AT_VLD(fa, 0);
        AT_KMM(fb, 3); AT_SB();
    } else if (DO_PV) { AT_VLD(fa, 0); AT_SB(); }
    float alpha = 1.f, mn = 0.f, mx = 0.f, ps = 0.f, rowfac = 0.f; bool need = false;
    f32x16& z0 = sn0; f32x16& z1 = sn1;
    if (DO_PV) { AT_VLD(fb, 1); AT_VMM(fa, 0); }
    if (DO_SM) {
        if (MODE == 0) {
#pragma unroll
            for (int h2 = 0; h2 < 2; ++h2) {
                const f32x4 c0a = *(LAS const f32x4*)(Cb + (16 * h2) * 4), c0b = *(LAS const f32x4*)(Cb + (16 * h2 + 4) * 4);
                const f32x4 c1a = *(LAS const f32x4*)(Cb + (32 + 16 * h2) * 4), c1b = *(LAS const f32x4*)(Cb + (32 + 16 * h2 + 4) * 4);
#pragma unroll
                for (int e = 0; e < 4; ++e) {
                    z0[8 * h2 + e] = fmaf(z0[8 * h2 + e], QSCALE * LOG2E, c0a[e]); z0[8 * h2 + 4 + e] = fmaf(z0[8 * h2 + 4 + e], QSCALE * LOG2E, c0b[e]);
                    z1[8 * h2 + e] = fmaf(z1[8 * h2 + e], QSCALE * LOG2E, c1a[e]); z1[8 * h2 + 4 + e] = fmaf(z1[8 * h2 + 4 + e], QSCALE * LOG2E, c1b[e]); }
            }
            if (MASK) {
#pragma unroll
                for (int r = 0; r < 16; ++r) { const int key = k0 + 16 * (r >> 3) + 8 * hi + (r & 7);
                    if (key > qi) z0[r] = -INFINITY;
                    if (key + 32 > qi) z1[r] = -INFINITY; }
            }
            mx = fmaxf(z0[0], z1[0]);
#pragma unroll
            for (int r = 1; r < 16; ++r) mx = fmaxf(mx, fmaxf(z0[r], z1[r]));
            { auto rr = __builtin_amdgcn_permlane32_swap(__float_as_uint(mx), __float_as_uint(mx), false, false); mx = fmaxf(__uint_as_float(rr[0]), __uint_as_float(rr[1])); }
        } else {
            mx = rb + *(LAS const float*)(lds + AT_CMOFF + (nt - 1 - i) * 4);
        }
        need = !__all(mx <= st.m + AT_THR);
        mn = need ? fmaxf(st.m, mx) : st.m;
        alpha = need ? __builtin_amdgcn_exp2f(st.m - mn) : 1.f; st.m = mn;
        if (MODE == 1) rowfac = QSCALE * __builtin_amdgcn_exp2f(mx - mn);
    }
    AT_SB();
    if (DO_PV) { AT_VLD(fa, 2); AT_VMM(fb, 1); }
    if (DO_SM) {
        if (MODE == 0) {
#pragma unroll
            for (int r = 0; r < 16; ++r) { const float p0 = __builtin_amdgcn_exp2f(z0[r] - mn); z0[r] = p0; ps += p0; }
        } else {
#pragma unroll
            for (int h2 = 0; h2 < 2; ++h2) { const f32x4 ca = *(LAS const f32x4*)(Cb + (16 * h2) * 4), cb4 = *(LAS const f32x4*)(Cb + (16 * h2 + 4) * 4);
#pragma unroll
                for (int e = 0; e < 8; ++e) { const int r = 8 * h2 + e; float p0 = z0[r] * ((e < 4 ? ca[e & 3] : cb4[e & 3]) * rowfac);
                    if (MASK) { if (k0 + 16 * h2 + 8 * hi + e > qi) p0 = 0.f; }
                    z0[r] = p0; ps += p0; } }
        }
    }
    AT_SB();
    if (DO_PV) { AT_VLD(fb, 3); AT_VMM(fa, 2); }
    if (DO_SM) {
        if (MODE == 0) {
#pragma unroll
            for (int r = 0; r < 16; ++r) { const float p1 = __builtin_amdgcn_exp2f(z1[r] - mn); z1[r] = p1; ps += p1; }
        } else {
#pragma unroll
            for (int h2 = 0; h2 < 2; ++h2) { const f32x4 ca = *(LAS const f32x4*)(Cb + (32 + 16 * h2) * 4), cb4 = *(LAS const f32x4*)(Cb + (32 + 16 * h2 + 4) * 4);
#pragma unroll
                for (int e = 0; e < 8; ++e) { const int r = 8 * h2 + e; float p1 = z1[r] * ((e < 4 ? ca[e & 3] : cb4[e & 3]) * rowfac);
                    if (MASK) { if (k0 + 32 + 16 * h2 + 8 * hi + e > qi) p1 = 0.f; }
                    z1[r] = p1; ps += p1; } }
        }
    }
    AT_SB();
    if (DO_PV) { AT_VMM(fb, 3); AT_SB(); }
    if (DO_SM) {
        st.lsum = st.lsum * alpha + ps;
#pragma unroll
        for (int j = 0; j < 2; ++j) {
            u32x4 w0 = {cvtpk(z0[8 * j + 0], z0[8 * j + 1]), cvtpk(z0[8 * j + 2], z0[8 * j + 3]), cvtpk(z0[8 * j + 4], z0[8 * j + 5]), cvtpk(z0[8 * j + 6], z0[8 * j + 7])};
            u32x4 w1 = {cvtpk(z1[8 * j + 0], z1[8 * j + 1]), cvtpk(z1[8 * j + 2], z1[8 * j + 3]), cvtpk(z1[8 * j + 4], z1[8 * j + 5]), cvtpk(z1[8 * j + 6], z1[8 * j + 7])};
            st.pbp[j] = __builtin_bit_cast(bf16x8, w0); st.pbp[2 + j] = __builtin_bit_cast(bf16x8, w1);
        }
        if (need) {
#pragma unroll
            for (int d = 0; d < 4; ++d)
#pragma unroll
                for (int r = 0; r < 16; ++r) st.o[d][r] *= alpha;
        }
    }
    }
    if (LAST) asm volatile("s_waitcnt vmcnt(0) lgkmcnt(0)" ::: "memory"); else asm volatile("s_waitcnt vmcnt(8) lgkmcnt(0)" ::: "memory");
    __builtin_amdgcn_s_barrier();
#undef AT_KLD
#undef AT_KMM
#undef AT_VLD
#undef AT_VMM
}

template <int MODE>
__device__ __forceinline__ void attn_unit(LAS unsigned char* lds, const bf16_t* __restrict__ Q, const bf16_t* __restrict__ K, int pitch, const bf16_t* __restrict__ Vt,
                                          const float* __restrict__ rowb, const float* __restrict__ colb, const float* __restrict__ cmaxt, bf16_t* O, const bf16_t* MO, const float* hg, int qb, float kn2) {
    const int tid = mytid(), w = __builtin_amdgcn_readfirstlane(tid >> 6), lane = tid & 63, q32 = lane & 31, hi = lane >> 5;
    const int r0 = qb * 256 + w * 32, qi = r0 + q32;
    AttnSt st;
#pragma unroll
    for (int db = 0; db < 8; ++db) st.qf[db] = *(const bf16x8*)(Q + (size_t)qi * pitch + db * 16 + hi * 8);
    const float rb = rowb[qi], cref = rowb[qb * 256];
    const int nt = 4 * (qb + 1);
    const int kr = 4 * w + (lane >> 4), krow = (kr & ~15) | ((kr & 4) << 1) | ((kr & 8) >> 1) | (kr & 3), kch = (lane & 15) ^ (kr & 15);
    const bf16_t* kgp = K + (size_t)krow * pitch + kch * 8;
    const int vr = 8 * w + (lane >> 3), vgr = (lane & 7) ^ ((vr >> 1) & 7);
    const bf16_t* vgp = Vt + (size_t)vr * M + vgr * 8;
    const int wofs = w * 1024;
    const int x = q32 & 15, y = (q32 >> 1) & 7;
    const unsigned kbase = q32 * 256 + ((hi ^ (x & 1)) << 4) + ((x >> 1) << 5);
    const unsigned vbase = q32 * 128 + ((hi ^ (y & 1)) << 4) + ((y >> 1) << 5);
    st.m = -1e30f; st.lsum = 0.f;
#pragma unroll
    for (int j = 0; j < 4; ++j) st.pbp[j] = (bf16x8){0, 0, 0, 0, 0, 0, 0, 0};
#pragma unroll
    for (int d = 0; d < 4; ++d)
#pragma unroll
        for (int r = 0; r < 16; ++r) st.o[d][r] = 0.f;
    {
        const bf16_t* gk0 = kgp + (size_t)((nt - 1) * 64) * pitch; const bf16_t* gk1 = kgp + (size_t)((nt - 2) * 64) * pitch; const bf16_t* gv0 = vgp + (nt - 1) * 64;
        LAS unsigned char* dk = lds + AT_KOFF + wofs; LAS unsigned char* dv = lds + AT_VOFF + wofs;
        __builtin_amdgcn_global_load_lds((const unsigned*)gk0, (LAS unsigned*)dk, 16, 0, 0);
        __builtin_amdgcn_global_load_lds((const unsigned*)(gk0 + (size_t)32 * pitch), (LAS unsigned*)(dk + 8192), 16, 0, 0);
        __builtin_amdgcn_global_load_lds((const unsigned*)gk1, (LAS unsigned*)(dk + AT_SLOT), 16, 0, 0);
        __builtin_amdgcn_global_load_lds((const unsigned*)(gk1 + (size_t)32 * pitch), (LAS unsigned*)(dk + AT_SLOT + 8192), 16, 0, 0);
        __builtin_amdgcn_global_load_lds((const unsigned*)gv0, (LAS unsigned*)dv, 16, 0, 0);
        __builtin_amdgcn_global_load_lds((const unsigned*)(gv0 + (size_t)64 * M), (LAS unsigned*)(dv + 8192), 16, 0, 0);
        { const bf16_t* gk2 = kgp + (size_t)((nt - 3) * 64) * pitch; const bf16_t* gv1 = vgp + (nt - 2) * 64;
          __builtin_amdgcn_global_load_lds((const unsigned*)gk2, (LAS unsigned*)(dk + 2 * AT_SLOT), 16, 0, 0);
          __builtin_amdgcn_global_load_lds((const unsigned*)(gk2 + (size_t)32 * pitch), (LAS unsigned*)(dk + 2 * AT_SLOT + 8192), 16, 0, 0);
          __builtin_amdgcn_global_load_lds((const unsigned*)gv1, (LAS unsigned*)(dv + AT_SLOT), 16, 0, 0);
          __builtin_amdgcn_global_load_lds((const unsigned*)(gv1 + (size_t)64 * M), (LAS unsigned*)(dv + AT_SLOT + 8192), 16, 0, 0); }
        for (int idx = tid; idx < nt * 16; idx += NTHR) { f32x4 c4 = *(const f32x4*)(colb + idx * 4); if (MODE == 0) c4 = c4 + cref; *(LAS f32x4*)(lds + AT_COFF + idx * 16) = c4; }
        if (MODE == 1) { if (tid < nt) *(LAS float*)(lds + AT_CMOFF + tid * 4) = cmaxt[tid]; }
        asm volatile("s_waitcnt vmcnt(0) lgkmcnt(0)" ::: "memory");
        __builtin_amdgcn_s_barrier();
    }
#define AT_ARGS lds, i, v3, nt, kgp, pitch, vgp, rb, kbase, vbase, wofs, hi, qi, r0
    int v3 = 0;
    { const int i = 0; attn_body<MODE, true, true, false, true, true, false>(st, AT_ARGS); v3 = 1; }
    for (int i = 1; i <= 3; ++i) { attn_body<MODE, true, true, true, true, true, false>(st, AT_ARGS); v3 = (v3 == 2) ? 0 : v3 + 1; }
    int i_end = nt;
    if (MODE == 0) {
        float q2 = 0.f;
#pragma unroll
        for (int db = 0; db < 8; ++db) { const u32x4 w = __builtin_bit_cast(u32x4, st.qf[db]); float u[8]; unpack8(w, u);
#pragma unroll
            for (int e = 0; e < 8; ++e) q2 += u[e] * u[e]; }
        { auto rr = __builtin_amdgcn_permlane32_swap(__float_as_uint(q2), __float_as_uint(q2), false, false); q2 = __uint_as_float(rr[0]) + __uint_as_float(rr[1]); }
        float mlo = st.m;
#pragma unroll
        for (int o = 1; o < 32; o <<= 1) { q2 = fmaxf(q2, __shfl_xor(q2, o)); mlo = fminf(mlo, __shfl_xor(mlo, o)); }
        LAS float* ex = (LAS float*)(lds + AT_CMOFF + 256);
        if (lane == 0) { ex[2 * w] = q2; ex[2 * w + 1] = mlo; }
        asm volatile("s_waitcnt lgkmcnt(0)" ::: "memory");
        __builtin_amdgcn_s_barrier();
        float q2u = ex[0], mlu = ex[1];
#pragma unroll
        for (int j = 1; j < 8; ++j) { q2u = fmaxf(q2u, ex[2 * j]); mlu = fminf(mlu, ex[2 * j + 1]); }
        const float sb = sqrtf(q2u * kn2) * (QSCALE * LOG2E) * 1.001f;
        const int ic = 4 + lane;
        bool dead = false;
        if (ic <= nt - 1) { const float ctop = *(LAS const float*)(lds + AT_COFF + ((nt - 1 - ic) * 64 + 63) * 4); dead = (sb + ctop - mlu) < -160.f; }
        const unsigned long long bal = __ballot(dead);
        if (bal) i_end = 4 + (int)__builtin_ctzll(bal);
    }
    for (int i = 4; i <= i_end - 1; ++i) { attn_body<MODE, true, true, true, false, true, false>(st, AT_ARGS); v3 = (v3 == 2) ? 0 : v3 + 1; }
    { const int i = i_end; attn_body<MODE, false, false, true, false, false, true>(st, AT_ARGS); }
#undef AT_ARGS
    float ltot;
    { auto rr = __builtin_amdgcn_permlane32_swap(__float_as_uint(st.lsum), __float_as_uint(st.lsum), false, false); ltot = __uint_as_float(rr[0]) + __uint_as_float(rr[1]); }
    float inv;
    if (MODE == 0) inv = 1.f / ltot;
    else {
        inv = 1.f / fmaxf(fabsf(ltot), __builtin_amdgcn_exp2f(-st.m));
        float ss = 0.f;
#pragma unroll
        for (int d = 0; d < 4; ++d)
#pragma unroll
            for (int r = 0; r < 16; ++r) { const float hv = st.o[d][r] * inv; ss += hv * hv; }
        { auto rr = __builtin_amdgcn_permlane32_swap(__float_as_uint(ss), __float_as_uint(ss), false, false); ss = __uint_as_float(rr[0]) + __uint_as_float(rr[1]); }
        inv *= rsqrtf(ss * (1.f / 128.f) + EPS);
    }
#pragma unroll
    for (int dbk = 0; dbk < 4; ++dbk)
#pragma unroll
        for (int g = 0; g < 4; ++g) {
            const int d = dbk * 32 + 8 * g + 4 * hi;
            float v0 = st.o[dbk][4 * g + 0] * inv, v1 = st.o[dbk][4 * g + 1] * inv, v2 = st.o[dbk][4 * g + 2] * inv, v3o = st.o[dbk][4 * g + 3] * inv;
            if (MODE == 1) {
                const f32x4 gg = *(const f32x4*)(hg + d); const u32x2 mo = *(const u32x2*)(MO + (size_t)qi * LDP + d);
                v0 *= gg[0] / (1.f + __expf(-bflo(mo.x))); v1 *= gg[1] / (1.f + __expf(-bfhi(mo.x)));
                v2 *= gg[2] / (1.f + __expf(-bflo(mo.y))); v3o *= gg[3] / (1.f + __expf(-bfhi(mo.y)));
            }
            u32x2 wv; wv.x = cvtpk(v0, v1); wv.y = cvtpk(v2, v3o);
            *(u32x2*)(O + (size_t)qi * D + d) = wv;
        }
}

__device__ __forceinline__ void attn_dispatch(const Args& a, int l, LAS unsigned char* lds, int bh, int qb) {
    unsigned char* ws = a.ws;
    const bf16_t* P = (const bf16_t*)(ws + WS_P); const bf16_t* QK = (const bf16_t*)(ws + WS_QK); const bf16_t* VT = (const bf16_t*)(ws + WS_VT);
    const float* rowb = (const float*)(ws + WS_ROWB); const float* colb = (const float*)(ws + WS_COLB); const float* cmaxt = (const float*)(ws + WS_CMAXT);
    bf16_t* CAT = (bf16_t*)(ws + WS_CAT);
    if (bh < 32) { const int b = bh >> 3, h = bh & 7; const size_t tok0 = (size_t)b * SEQ;
        attn_unit<0>(lds, P + tok0 * LDP + 2048 + h * 128, P + tok0 * LDP + 3072 + h * 128, LDP, VT + (size_t)(512 + h * 128) * M + tok0,
                     rowb + (size_t)(b * 12 + 4 + h) * SEQ, colb + (size_t)(b * 12 + 4 + h) * SEQ, nullptr, CAT + tok0 * D + 1024 + h * 128, nullptr, nullptr, qb,
                     __uint_as_float(((const unsigned*)(ws + WS_BAR))[3968 + 32 * l + b * 8 + h]));
    } else { const int b2 = (bh - 32) >> 2, h = (bh - 32) & 3; const size_t tok0 = (size_t)b2 * SEQ;
        attn_unit<1>(lds, QK + tok0 * 1024 + h * 128, QK + tok0 * 1024 + 512 + h * 128, 1024, VT + (size_t)(h * 128) * M + tok0,
                     rowb + (size_t)(b2 * 12 + h) * SEQ, colb + (size_t)(b2 * 12 + h) * SEQ, cmaxt + (size_t)(b2 * 12 + h) * 64, CAT + tok0 * D + h * 128, P + tok0 * LDP + 1024 + h * 128,
                     a.in[12] + (size_t)l * 512 + h * 128, qb, 0.f);
    }
}

__global__ void __launch_bounds__(NTHR, 2) mega_fwd(Args a) {
    extern __shared__ __attribute__((aligned(16))) unsigned char lds_raw[];
    LAS unsigned char* lds = (LAS unsigned char*)lds_raw;
    const int G = gridDim.x, NGW = G * NWAVES;
    unsigned char* ws = a.ws;
    if (threadIdx.x < 64) ((LAS unsigned*)(lds + 151552))[threadIdx.x] = 0u;
    __syncthreads();
    const XcdBarrier bar = xcd_barrier_post((unsigned*)(ws + WS_BAR), (volatile LAS unsigned*)(lds + 151552));
    bf16_t* XN = (bf16_t*)(ws + WS_XN); float* RINV = (float*)(ws + WS_RINV);
    for (int ph = a.ph_lo; ph < a.ph_hi; ++ph) {
        const int tid = mytid(), lane = tid & 63, wave = __builtin_amdgcn_readfirstlane(tid >> 6);
        const int gw = blockIdx.x * NWAVES + wave;
        if (ph == 0) {
#ifndef NO_P0
            p0_weights(a, lds, gw, NGW, wave, lane);
#endif
            norm_rows<true, false, false>(a.in[0], XN, nullptr, nullptr, 0.f, RINV, gw, NGW, lane);
        } else {
            const int l = (ph - 1) / 11, s = (ph - 1) % 11;
            unsigned char* wl = ws + (size_t)l * WS_WL;
            if (s == 0 || s == 8) {
                pg8::Gemm g{XN, (const bf16_t*)(wl + (s == 0 ? W_BT1 : W_BT2)), M, 2 * FF, D}; pg8::StaticOrder S; S.init(M, 2 * FF, G, (int)blockIdx.x);
                pg8::EpiSwiglu E{(bf16_t*)(ws + WS_BIG), FF};
                pg8::gemm_phase<pg8::EpiSwiglu, pg8::StaticOrder, true, true>(lds, g, S, E);
            } else if (s == 1 || s == 9 || s == 6) {
                pg8::Gemm g{}; g.M = M; g.N = D;
                if (s == 6) { g.A = (const bf16_t*)(ws + WS_CAT); g.Bt = (const bf16_t*)(wl + W_WOUT); g.K = D; }
                else { g.A = (const bf16_t*)(ws + WS_BIG); g.Bt = (const bf16_t*)(wl + (s == 1 ? W_WD1 : W_WD2)); g.K = FF; }
                pg8::StaticOrder S; S.init(M, D, G, (int)blockIdx.x);
                pg8::EpiStore E{(bf16_t*)(ws + (s == 6 ? WS_H_MIX : WS_H_FFN)), D};
                pg8::gemm_phase<pg8::EpiStore, pg8::StaticOrder, true, true>(lds, g, S, E);
            } else if (s == 2 || s == 7 || s == 10) {
                const float* post_g = a.in[s == 2 ? 2 : (s == 7 ? 7 : 18)] + (size_t)l * D;
                const float wgt = (s == 7) ? 1.f : 0.5f;
                const bool wx = !(s == 10 && l == DEPTH - 1);
                const bf16_t* Hh = (const bf16_t*)(ws + (s == 7 ? WS_H_MIX : WS_H_FFN));
                if (wx) norm_rows<false, true, false>(XN, XN, Hh, post_g, wgt, RINV, gw, NGW, lane);
                else norm_rows<false, true, true>(XN, a.out, Hh, post_g, wgt, RINV, gw, NGW, lane);
            } else if (s == 3) {
                pg8::Gemm g{XN, (const bf16_t*)(wl + W_WIN), M, NP, D, (const bf16_t*)(wl + W_WV), XN}; pg8::DualOrder S; S.init(M, NP, NV, M, G, (int)blockIdx.x);
                pg8::EpiWinDual E{pg8::EpiWin{(bf16_t*)(ws + WS_P), LDP, (float*)(ws + WS_GATES), GATE_PN}, pg8::EpiStore{(bf16_t*)(ws + WS_VT), M}};
                pg8::gemm_phase<pg8::EpiWinDual, pg8::DualOrder, true, true>(lds, g, S, E);
            } else if (s == 4) {
#ifndef NO_PREP
                prep_phase(a, l, lds);
#endif
            } else if (s == 5) {
                { pg8::Gemm g{(const bf16_t*)(ws + WS_DPOOL), (const bf16_t*)(wl + W_WPOOL), M, 512, 512}; pg8::StaticOrder S; S.init(M, 512, G, (int)blockIdx.x);
                  pg8::EpiPool E{(bf16_t*)(ws + WS_CAT) + 512, D, a.in[14] + (size_t)l * 512};
                  pg8::gemm_phase<pg8::EpiPool, pg8::StaticOrder, true, true>(lds, g, S, E); }
                __syncthreads();
#ifndef NO_ATTN
                {
                    unsigned* ctr = (unsigned*)(ws + WS_BAR) + 3840 + 64 * l;
                    volatile LAS unsigned* nxt = (volatile LAS unsigned*)(lds + 151552 + 256);
                    for (;;) {
                        if (tid == 0) *nxt = __hip_atomic_fetch_add(ctr, 1u, __ATOMIC_RELAXED, __HIP_MEMORY_SCOPE_AGENT);
                        __syncthreads();
                        const int u = (int)*nxt;
                        __syncthreads();
                        if (u >= 48 * 16) break;
                        attn_dispatch(a, l, lds, u % 48, 15 - u / 48);
                    }
                }
#endif
            }
        }
        if (ph + 1 < a.ph_hi) { if (ph == 0) cg::this_grid().sync(); else xcd_barrier(bar); }
    }
}

extern "C" void kernel_launch(void* const* d_in, const int* in_sizes, int n_in, void* d_out, int out_size, void* d_ws, size_t ws_size, hipStream_t stream) {
    static int grid = 0;
    if (grid == 0) {
        if (n_in != 22 || out_size != M * D || ws_size < WS_END) { fprintf(stderr, "kernel_launch: unexpected shapes (n_in %d out %d ws %zu need %zu)\n", n_in, out_size, ws_size, (size_t)WS_END); grid = -1; return; }
        int dev = 0, cus = 0, per_cu = 0;
        hipGetDevice(&dev); hipDeviceGetAttribute(&cus, hipDeviceAttributeMultiprocessorCount, dev);
        if (hipFuncSetAttribute((const void*)mega_fwd, hipFuncAttributeMaxDynamicSharedMemorySize, LDS_BYTES) != hipSuccess) { fprintf(stderr, "kernel_launch: hipFuncSetAttribute failed\n"); grid = -1; return; }
        if (hipOccupancyMaxActiveBlocksPerMultiprocessor(&per_cu, (const void*)mega_fwd, NTHR, LDS_BYTES) != hipSuccess || per_cu < 1) per_cu = 1;
        (void)hipGetLastError();
        grid = cus * per_cu;
        if (grid > cus) grid = cus;
    }
    if (grid < 0) return;
    if (hipMemsetAsync((char*)d_ws + WS_BAR, 0, BAR_BYTES, stream) != hipSuccess) { fprintf(stderr, "kernel_launch: memset failed\n"); return; }
    Args a{};
    for (int i = 0; i < 22; ++i) a.in[i] = (const float*)d_in[i];
    a.out = (float*)d_out; a.ws = (unsigned char*)d_ws;
#if MK_COOP
    a.ph_lo = 0; a.ph_hi = NPHASE;
    void* kargs[] = {&a};
    hipError_t e = hipLaunchCooperativeKernel((const void*)mega_fwd, dim3(grid), dim3(NTHR), kargs, LDS_BYTES, stream);
    if (e != hipSuccess) fprintf(stderr, "cooperative launch failed: %s (grid %d)\n", hipGetErrorString(e), grid);
#else
    for (int ph = 0; ph < NPHASE; ++ph) {
        a.ph_lo = ph; a.ph_hi = ph + 1;
        hipLaunchKernelGGL(mega_fwd, dim3(grid), dim3(NTHR), LDS_BYTES, stream, a);
    }
#endif
}
```

```cpp
#include <hip/hip_runtime.h>
#include <hip/hip_cooperative_groups.h>
#include <cstdio>
#include <cstdint>
namespace cg = cooperative_groups;

#ifndef MK_COOP
#define MK_COOP 1
#endif

__device__ __forceinline__ int mytid() { int t = threadIdx.x; asm volatile("" : "+v"(t)); return t; }
namespace pg8 {
#define PG8_LAS __attribute__((address_space(3)))
typedef unsigned short bf16_t;
typedef short bf16x8 __attribute__((ext_vector_type(8)));
typedef float f32x4 __attribute__((ext_vector_type(4)));
typedef unsigned u32x4 __attribute__((ext_vector_type(4)));
constexpr int BM = 256, BK = 64, HALF = 128, HTB = HALF * BK * 2  , STAGE_BYTES = 8 * HTB, NXCD = 8, WGM = 8;

__host__ __device__ __forceinline__ int lds_byte(int r, int c) { const int st = (r >> 4) * 2 + (c >> 5), rr = r & 15, cc = c & 31, ob = rr * 64 + cc * 2; return st * 1024 + (ob ^ (((ob >> 9) & 1) << 5)); }
__host__ __device__ __forceinline__ void stage_rc(int b, int& R, int& C) { const int st = b / 1024, sb = b % 1024, swz = sb ^ (((sb >> 9) & 1) << 5); R = (st >> 1) * 16 + swz / 64; C = (st & 1) * 32 + (swz % 64) / 2; }
__host__ __device__ __forceinline__ int perm32(int rho) { const int n = rho >> 4, i = rho & 15; return 8 * (i >> 2) + 4 * n + (i & 3); }

struct Unit { int pm, pn, job; };
struct Gemm { const bf16_t* A; const bf16_t* Bt; int M, N, K; const bf16_t* A2; const bf16_t* Bt2; };

struct StaticOrder {
    int nM, nN, nwg, G, c;
    __host__ __device__ void init(int M, int N, int G_, int c_) { nM = M / BM; nN = N / BM; nwg = nM * nN; G = G_; c = c_; }
    __host__ __device__ void map(long L, Unit& u) const {
        int wgid = (int)L; { const int q = nwg / NXCD, r = nwg % NXCD, xcd = wgid % NXCD, off = wgid / NXCD; wgid = (xcd < r ? xcd * (q + 1) : r * (q + 1) + (xcd - r) * q) + off; }
        const int nig = WGM * nN, gid = wgid / nig, fm = gid * WGM, gsz = (nM - fm) < WGM ? (nM - fm) : WGM;
        u.pm = fm + ((wgid % nig) % gsz); u.pn = (wgid % nig) / gsz; u.job = 0;
    }
    __host__ __device__ bool next(int i, Unit& u) const {
        const long L = (long)i * G + c; if (L >= nwg) return false;
        map(L, u); return true;
    }
    __device__ __forceinline__ void a_ready(const Unit&) const {}
    __device__ __forceinline__ void done(const Unit&) const {}
};

struct DualOrder {
    StaticOrder o1, o2;
    __host__ __device__ void init(int M1, int N1, int M2, int N2, int G_, int c_) { o1.init(M1, N1, G_, c_); o2.init(M2, N2, G_, c_); }
    __host__ __device__ bool next(int i, Unit& u) const {
        const long L = (long)i * o1.G + o1.c;
        if (L < o1.nwg) { o1.map(L, u); return true; }
        if (L - o1.nwg >= o2.nwg) return false;
        o2.map(L - o1.nwg, u); u.job = 1; return true;
    }
    __device__ __forceinline__ void a_ready(const Unit&) const {}
    __device__ __forceinline__ void done(const Unit&) const {}
};
__device__ __forceinline__ unsigned cvt_pk_bf16(float lo, float hi) { unsigned r; asm volatile("v_cvt_pk_bf16_f32 %0, %1, %2" : "=v"(r) : "v"(lo), "v"(hi)); return r; }

struct EpiStore {
    static constexpr bool PERM = true, AFTER_DRAIN = false;
    bf16_t* O; int ldc;
    __device__ __forceinline__ void operator()(const f32x4 (&acc)[2][2][4][2], const Unit& u, int wr, int wc, int fr, int fq) const {
        const int row0 = u.pm * BM + wr * 64 + fr, col0 = u.pn * BM + wc * 32 + 8 * fq;
#pragma unroll
        for (int ai = 0; ai < 2; ++ai)
#pragma unroll
            for (int m = 0; m < 4; ++m) { bf16_t* rowp = O + (size_t)(row0 + ai * HALF + m * 16) * ldc + col0;
#pragma unroll
                for (int bj = 0; bj < 2; ++bj) { const f32x4 v0 = acc[ai][bj][m][0], v1 = acc[ai][bj][m][1];
                    u32x4 w; w.x = cvt_pk_bf16(v0[0], v0[1]); w.y = cvt_pk_bf16(v0[2], v0[3]); w.z = cvt_pk_bf16(v1[0], v1[1]); w.w = cvt_pk_bf16(v1[2], v1[3]);
                    *(u32x4*)(rowp + bj * HALF) = w; } }
    }
};
__device__ __forceinline__ float silu_mul(float g, float u) { return g * __builtin_amdgcn_rcpf(1.f + __builtin_amdgcn_exp2f(-1.4426950408889634f * g)) * u; }
struct EpiSwiglu {
    static constexpr bool PERM = true, AFTER_DRAIN = false;
    bf16_t* O; int ldc;
    __device__ __forceinline__ void operator()(const f32x4 (&acc)[2][2][4][2], const Unit& u, int wr, int wc, int fr, int fq) const {
        const int row0 = u.pm * BM + wr * 64 + fr, col0 = u.pn * HALF + wc * 32 + 8 * fq;
#pragma unroll
        for (int ai = 0; ai < 2; ++ai)
#pragma unroll
            for (int m = 0; m < 4; ++m) { bf16_t* rowp = O + (size_t)(row0 + ai * HALF + m * 16) * ldc + col0;
                const f32x4 g0 = acc[ai][0][m][0], g1 = acc[ai][0][m][1], u0 = acc[ai][1][m][0], u1 = acc[ai][1][m][1];
                u32x4 w; w.x = cvt_pk_bf16(silu_mul(g0[0], u0[0]), silu_mul(g0[1], u0[1])); w.y = cvt_pk_bf16(silu_mul(g0[2], u0[2]), silu_mul(g0[3], u0[3]));
                w.z = cvt_pk_bf16(silu_mul(g1[0], u1[0]), silu_mul(g1[1], u1[1])); w.w = cvt_pk_bf16(silu_mul(g1[2], u1[2]), silu_mul(g1[3], u1[3]));
                *(u32x4*)rowp = w; }
    }
};
struct EpiWin {
    static constexpr bool PERM = true, AFTER_DRAIN = false;
    bf16_t* O; int ldc; float* G; int gate_pn;
    __device__ __forceinline__ void operator()(const f32x4 (&acc)[2][2][4][2], const Unit& u, int wr, int wc, int fr, int fq) const {
        const int row0 = u.pm * BM + wr * 64 + fr, col0 = u.pn * BM + wc * 32 + 8 * fq;
        if (u.pn < gate_pn) {
#pragma unroll
            for (int ai = 0; ai < 2; ++ai)
#pragma unroll
                for (int m = 0; m < 4; ++m) { bf16_t* rowp = O + (size_t)(row0 + ai * HALF + m * 16) * ldc + col0;
#pragma unroll
                    for (int bj = 0; bj < 2; ++bj) { const f32x4 v0 = acc[ai][bj][m][0], v1 = acc[ai][bj][m][1];
                        u32x4 w; w.x = cvt_pk_bf16(v0[0], v0[1]); w.y = cvt_pk_bf16(v0[2], v0[3]); w.z = cvt_pk_bf16(v1[0], v1[1]); w.w = cvt_pk_bf16(v1[2], v1[3]);
                        *(u32x4*)(rowp + bj * HALF) = w; } }
        } else if (wc == 0 && fq < 2) {
#pragma unroll
            for (int ai = 0; ai < 2; ++ai)
#pragma unroll
                for (int m = 0; m < 4; ++m) { float* gp = G + (size_t)(row0 + ai * HALF + m * 16) * 16 + 8 * fq;
                    *(f32x4*)gp = acc[ai][0][m][0]; *(f32x4*)(gp + 4) = acc[ai][0][m][1]; }
        }
    }
};
struct EpiWinDual {
    static constexpr bool PERM = true, AFTER_DRAIN = false;
    EpiWin e1; EpiStore e2;
    __device__ __forceinline__ void operator()(const f32x4 (&acc)[2][2][4][2], const Unit& u, int wr, int wc, int fr, int fq) const {
        if (u.job) e2(acc, u, wr, wc, fr, fq); else e1(acc, u, wr, wc, fr, fq);
    }
};
struct EpiPool {
    static constexpr bool PERM = true, AFTER_DRAIN = false;
    bf16_t* O; int ldc; const float* scale;
    __device__ __forceinline__ void operator()(const f32x4 (&acc)[2][2][4][2], const Unit& u, int wr, int wc, int fr, int fq) const {
        const int row0 = u.pm * BM + wr * 64 + fr, col0 = u.pn * BM + wc * 32 + 8 * fq;
#pragma unroll
        for (int ai = 0; ai < 2; ++ai)
#pragma unroll
            for (int m = 0; m < 4; ++m) { bf16_t* rowp = O + (size_t)(row0 + ai * HALF + m * 16) * ldc + col0;
#pragma unroll
                for (int bj = 0; bj < 2; ++bj) { const f32x4 s0 = *(const f32x4*)(scale + col0 + bj * HALF), s1 = *(const f32x4*)(scale + col0 + bj * HALF + 4);
                    const f32x4 v0 = acc[ai][bj][m][0] * s0, v1 = acc[ai][bj][m][1] * s1;
                    u32x4 w; w.x = cvt_pk_bf16(v0[0], v0[1]); w.y = cvt_pk_bf16(v0[2], v0[3]); w.z = cvt_pk_bf16(v1[0], v1[1]); w.w = cvt_pk_bf16(v1[2], v1[3]);
                    *(u32x4*)(rowp + bj * HALF) = w; } }
    }
};


template <class Epi, class Sched, bool ALIGN_EPI = false, bool SP2 = false>
__device__ __forceinline__ void gemm_phase(PG8_LAS unsigned char* lds, const Gemm g, const Sched& S, const Epi& E) {
    const int tid = mytid(), wid = __builtin_amdgcn_readfirstlane(tid >> 6), lane = tid & 63, wr = wid >> 2, wc = wid & 3, fr = lane & 15, fq = lane >> 4;
    const int K = g.K, nt = K / BK;
    unsigned voffA[2], voffB[2];
#pragma unroll
    for (int i = 0; i < 2; ++i) { int R, C; stage_rc(tid * 16 + i * 8192, R, C); const int Rb = Epi::PERM ? ((R & ~31) + perm32(R & 31)) : R;
        voffA[i] = (unsigned)(R * K + C) * 2u; voffB[i] = (unsigned)(Rb * K + C) * 2u; }
    const size_t kstep = (size_t)(BK * 2);
    const size_t hstep = (size_t)HALF * K * 2;
    const size_t tstep = 2 * hstep;
    const unsigned ldsw = (unsigned)wid * 1024u;
    const int aoff = lds_byte(wr * 64 + fr, fq * 8), boff = lds_byte(wc * 32 + fr, fq * 8);
#define PG8_SA(b, h) (((b) * 2 + (h)) * HTB)
#define PG8_SB(b, h) ((4 + (b) * 2 + (h)) * HTB)
#define PG8_STAGE(bufoff, gbase, voff) do { _Pragma("unroll") for (int _i = 0; _i < 2; ++_i) \
        __builtin_amdgcn_global_load_lds((const unsigned*)((const char*)(gbase) + (voff)[_i]), (PG8_LAS unsigned*)(lds + (bufoff) + ldsw + _i * 8192), 16, 0, 0); } while (0)
#define PG8_LDA(dst, b, h) do { _Pragma("unroll") for (int m = 0; m < 4; ++m) _Pragma("unroll") for (int k = 0; k < 2; ++k) dst[m][k] = *(const PG8_LAS bf16x8*)(lds + PG8_SA(b, h) + aoff + m * 2048 + k * 1024); } while (0)
#define PG8_LDB(dst, b, h) do { _Pragma("unroll") for (int n = 0; n < 2; ++n) _Pragma("unroll") for (int k = 0; k < 2; ++k) dst[n][k] = *(const PG8_LAS bf16x8*)(lds + PG8_SB(b, h) + boff + n * 2048 + k * 1024); } while (0)
#define PG8_MMA(ai, bj, At, Bt) do { __builtin_amdgcn_s_setprio(1); _Pragma("unroll") for (int m = 0; m < 4; ++m) _Pragma("unroll") for (int n = 0; n < 2; ++n) _Pragma("unroll") for (int k = 0; k < 2; ++k) \
        acc[ai][bj][m][n] = __builtin_amdgcn_mfma_f32_16x16x32_bf16(Bt[n][k], At[m][k], acc[ai][bj][m][n], 0, 0, 0); __builtin_amdgcn_s_setprio(0); } while (0)
#define PG8_WAIT_V(n) asm volatile("s_waitcnt vmcnt(" #n ")" ::: "memory")
#define PG8_WAIT_L(n) asm volatile("s_waitcnt lgkmcnt(" #n ")" ::: "memory")
#define PG8_BAR __builtin_amdgcn_s_barrier()
#define PG8_SCHED __builtin_amdgcn_sched_barrier(0)
    Unit cur, nxt; int ui = 0;
    if (!S.next(0, cur)) return;
    f32x4 acc[2][2][4][2];
#pragma unroll
    for (int a = 0; a < 2; ++a)
#pragma unroll
        for (int b = 0; b < 2; ++b)
#pragma unroll
            for (int m = 0; m < 4; ++m)
#pragma unroll
                for (int n = 0; n < 2; ++n) acc[a][b][m][n] = (f32x4){0.f, 0.f, 0.f, 0.f};
    bf16x8 At[4][2], B0[2][2], B1[2][2];
    const char* cA = (const char*)(cur.job ? g.A2 : g.A) + (size_t)cur.pm * tstep; const char* cB = (const char*)(cur.job ? g.Bt2 : g.Bt) + (size_t)cur.pn * tstep;
    S.a_ready(cur);
    if constexpr (SP2) {
        PG8_STAGE(PG8_SB(0, 0), cB, voffB); PG8_STAGE(PG8_SB(0, 1), cB + hstep, voffB); PG8_STAGE(PG8_SA(0, 0), cA, voffA); PG8_STAGE(PG8_SA(0, 1), cA + hstep, voffA);
        if (wr == 1) PG8_BAR;
        PG8_WAIT_V(2); PG8_BAR;
        PG8_STAGE(PG8_SB(1, 0), cB + kstep, voffB); PG8_STAGE(PG8_SA(1, 0), cA + kstep, voffA); PG8_STAGE(PG8_SB(1, 1), cB + hstep + kstep, voffB);
        PG8_WAIT_V(6); PG8_BAR;
    } else {
        PG8_STAGE(PG8_SB(0, 0), cB, voffB); PG8_STAGE(PG8_SA(0, 0), cA, voffA); PG8_STAGE(PG8_SB(0, 1), cB + hstep, voffB); PG8_STAGE(PG8_SA(0, 1), cA + hstep, voffA);
        if (wr == 1) PG8_BAR;
        PG8_WAIT_V(4); PG8_BAR;
        PG8_STAGE(PG8_SB(1, 0), cB + kstep, voffB); PG8_STAGE(PG8_SA(1, 0), cA + kstep, voffA); PG8_STAGE(PG8_SB(1, 1), cB + hstep + kstep, voffB);
        PG8_WAIT_V(6); PG8_BAR;
    }
    for (;;) {
        const bool has_next = S.next(ui + 1, nxt);
        const char* nA = has_next ? (const char*)(nxt.job ? g.A2 : g.A) + (size_t)nxt.pm * tstep : cA; const char* nB = has_next ? (const char*)(nxt.job ? g.Bt2 : g.Bt) + (size_t)nxt.pn * tstep : cB;
        for (int t = 0; t < nt; t += 2) {
            const bool last = (t == nt - 2);
            const char* a1 = cA + (size_t)(t + 1) * kstep;
            const char* a2 = last ? nA : cA + (size_t)(t + 2) * kstep; const char* b2 = last ? nB : cB + (size_t)(t + 2) * kstep;
            const char* a3 = a2 + kstep; const char* b3 = b2 + kstep;
            if (last && has_next) S.a_ready(nxt);
            if constexpr (SP2) {
            PG8_LDB(B0, 0, 0); PG8_LDB(B1, 0, 1); PG8_SCHED; PG8_LDA(At, 0, 0); PG8_STAGE(PG8_SA(1, 1), a1 + hstep, voffA);
            PG8_WAIT_V(8); PG8_WAIT_L(0); PG8_BAR; PG8_MMA(0, 0, At, B0); PG8_MMA(0, 1, At, B1); PG8_BAR; PG8_SCHED;
            PG8_LDA(At, 0, 1); PG8_STAGE(PG8_SB(0, 0), b2, voffB); PG8_STAGE(PG8_SB(0, 1), b2 + hstep, voffB); PG8_STAGE(PG8_SA(0, 0), a2, voffA);
            PG8_WAIT_V(8); PG8_WAIT_L(0); PG8_BAR; PG8_MMA(1, 0, At, B0); PG8_MMA(1, 1, At, B1); PG8_BAR; PG8_SCHED;
            PG8_LDB(B0, 1, 0); PG8_LDB(B1, 1, 1); PG8_SCHED; PG8_LDA(At, 1, 0); PG8_STAGE(PG8_SA(0, 1), a2 + hstep, voffA);
            PG8_WAIT_V(8); PG8_WAIT_L(0); PG8_BAR; PG8_MMA(0, 0, At, B0); PG8_MMA(0, 1, At, B1); PG8_BAR; PG8_SCHED;
            PG8_LDA(At, 1, 1); PG8_STAGE(PG8_SB(1, 0), b3, voffB); PG8_STAGE(PG8_SB(1, 1), b3 + hstep, voffB); PG8_STAGE(PG8_SA(1, 0), a3, voffA);
            PG8_WAIT_V(8); PG8_WAIT_L(0); PG8_BAR; PG8_MMA(1, 0, At, B0); PG8_MMA(1, 1, At, B1); PG8_BAR; PG8_SCHED;
            } else {
            PG8_LDB(B0, 0, 0); PG8_SCHED; PG8_LDA(At, 0, 0); PG8_STAGE(PG8_SA(1, 1), a1 + hstep, voffA);
            PG8_WAIT_L(8); PG8_BAR; PG8_WAIT_L(0); PG8_MMA(0, 0, At, B0); PG8_BAR; PG8_SCHED;
            PG8_LDB(B1, 0, 1); PG8_STAGE(PG8_SB(0, 0), b2, voffB);
            PG8_BAR; PG8_WAIT_L(0); PG8_MMA(0, 1, At, B1); PG8_BAR;
            PG8_LDA(At, 0, 1); PG8_STAGE(PG8_SA(0, 0), a2, voffA);
            PG8_BAR; PG8_WAIT_L(0); PG8_MMA(1, 0, At, B0); PG8_BAR; PG8_SCHED;
            PG8_STAGE(PG8_SB(0, 1), b2 + hstep, voffB);
            PG8_WAIT_V(6); PG8_BAR; PG8_MMA(1, 1, At, B1); PG8_BAR;
            PG8_LDB(B0, 1, 0); PG8_SCHED; PG8_LDA(At, 1, 0); PG8_STAGE(PG8_SA(0, 1), a2 + hstep, voffA);
            PG8_WAIT_L(8); PG8_BAR; PG8_WAIT_L(0); PG8_MMA(0, 0, At, B0); PG8_BAR; PG8_SCHED;
            PG8_LDB(B1, 1, 1); PG8_STAGE(PG8_SB(1, 0), b3, voffB);
            PG8_BAR; PG8_WAIT_L(0); PG8_MMA(0, 1, At, B1); PG8_BAR;
            PG8_LDA(At, 1, 1); PG8_STAGE(PG8_SA(1, 0), a3, voffA);
            PG8_BAR; PG8_WAIT_L(0); PG8_MMA(1, 0, At, B0); PG8_BAR; PG8_SCHED;
            PG8_STAGE(PG8_SB(1, 1), b3 + hstep, voffB);
            PG8_WAIT_V(6); PG8_BAR; PG8_MMA(1, 1, At, B1); PG8_BAR;
            }
        }
        if constexpr (ALIGN_EPI) { if (wr == 0) PG8_BAR; }
        if constexpr (!Epi::AFTER_DRAIN) { E(acc, cur, wr, wc, fr, fq); S.done(cur); }
        if (!has_next) break;
#pragma unroll
        for (int a = 0; a < 2; ++a)
#pragma unroll
            for (int b = 0; b < 2; ++b)
#pragma unroll
                for (int m = 0; m < 4; ++m)
#pragma unroll
                    for (int n = 0; n < 2; ++n) acc[a][b][m][n] = (f32x4){0.f, 0.f, 0.f, 0.f};
        cur = nxt; cA = nA; cB = nB; ++ui;
        if constexpr (ALIGN_EPI) { if (wr == 1) PG8_BAR; }
    }
    PG8_WAIT_V(0);
    if constexpr (!ALIGN_EPI) { if (wr == 0) PG8_BAR; }
    PG8_BAR;
    if constexpr (Epi::AFTER_DRAIN) { E.fused(acc, cur, wr, wc, fr, fq, lds, wid, lane); S.done(cur); }
#undef PG8_SA
#undef PG8_SB
#undef PG8_STAGE
#undef PG8_LDA
#undef PG8_LDB
#undef PG8_MMA
#undef PG8_WAIT_V
#undef PG8_WAIT_L
#undef PG8_BAR
#undef PG8_SCHED
}}

#define LAS __attribute__((address_space(3)))
typedef unsigned short bf16_t;
typedef short bf16x8 __attribute__((ext_vector_type(8)));
typedef short s16x4 __attribute__((ext_vector_type(4)));
typedef float f32x4 __attribute__((ext_vector_type(4)));
typedef float f32x16 __attribute__((ext_vector_type(16)));
typedef unsigned u32x4 __attribute__((ext_vector_type(4)));
typedef unsigned u32x2 __attribute__((ext_vector_type(2)));
typedef float f32x2_t __attribute__((ext_vector_type(2)));
typedef __bf16 bf16x2_t __attribute__((ext_vector_type(2)));

constexpr int NB = 4, SEQ = 4096, M = NB * SEQ, D = 2048, FF = 5632, NIN = 5648, DEPTH = 2;
constexpr int NP = 4352, LDP = 4096, GATE_PN = 16, NV = 1536;
constexpr float EPS = 1e-6f, LOG2E = 1.4426950408889634f, QSCALE = 0.08838834764831845f;
constexpr int NWAVES = 8, NTHR = 512;
constexpr int LDS_BYTES = 155648;
constexpr int NPHASE = 1 + 11 * DEPTH;

constexpr size_t MiB = 1u << 20;
constexpr size_t WS_WL = 164 * MiB;
constexpr size_t W_BT1 = 0, W_WD1 = 44 * MiB, W_BT2 = 66 * MiB, W_WD2 = 110 * MiB, W_WIN = 132 * MiB, W_WV = 149 * MiB, W_WOUT = 155 * MiB, W_WPOOL = 163 * MiB;
constexpr size_t WS_XN = 328 * MiB, WS_XB = 392 * MiB  , WS_GATES = 456 * MiB, WS_ROWB = 457 * MiB, WS_COLB = 458 * MiB;
constexpr size_t WS_CMAXT = 457 * MiB + 768 * 1024;
constexpr size_t WS_RINV = 458 * MiB + 768 * 1024;
constexpr size_t WS_BAR = 459 * MiB, BAR_BYTES = 16384;
constexpr size_t WS_BIG = 460 * MiB;
constexpr size_t WS_P = WS_BIG, WS_VT = WS_BIG + 128 * MiB, WS_QK = WS_BIG + 176 * MiB, WS_DPOOL = WS_BIG + 208 * MiB, WS_CAT = WS_BIG + 224 * MiB;
constexpr size_t WS_END = WS_BIG + 288 * MiB;
constexpr size_t WS_H_FFN = WS_BIG + 176 * MiB, WS_H_MIX = WS_BIG;

__device__ __forceinline__ unsigned f2bf(float f) { unsigned u = __builtin_bit_cast(unsigned, f); return (u + 0x7fffu + ((u >> 16) & 1u)) >> 16; }
__device__ __forceinline__ unsigned pk2(float lo, float hi) { return f2bf(lo) | (f2bf(hi) << 16); }
__device__ __forceinline__ unsigned cvtpk(float lo, float hi) { f32x2_t v = {lo, hi}; bf16x2_t b = __builtin_convertvector(v, bf16x2_t); return __builtin_bit_cast(unsigned, b); }
__device__ __forceinline__ float bflo(unsigned w) { return __builtin_bit_cast(float, w << 16); }
__device__ __forceinline__ float bfhi(unsigned w) { return __builtin_bit_cast(float, w & 0xffff0000u); }
#define LDS_WAIT() asm volatile("s_waitcnt lgkmcnt(0)" ::: "memory")
__device__ __forceinline__ float wave_sum(float v) {
#pragma unroll
    for (int o = 1; o < 64; o <<= 1) v += __shfl_xor(v, o);
    return v;
}

typedef __attribute__((address_space(1))) unsigned gu32;
#define XB_TMO      128
#define XB_XCNT(j)  (256  + 64 * (j))
#define XB_XSUB(j)  (1280 + 64 * (j))
#define XB_XGEN(j)  (2304 + 64 * (j))
#define XB_TOP      3328
#define XB_TOPGEN   3392
#define XCD_BAR_WORDS 3456
#define XB_SPIN_CAP (1u << 18)

__device__ __forceinline__ unsigned xb_ld(unsigned* p)              { return __hip_atomic_load(p, __ATOMIC_RELAXED, __HIP_MEMORY_SCOPE_AGENT); }
__device__ __forceinline__ unsigned xb_add(unsigned* p, unsigned v) { return __hip_atomic_fetch_add(p, v, __ATOMIC_RELAXED, __HIP_MEMORY_SCOPE_AGENT); }
__device__ __forceinline__ unsigned xb_xcc_id() { return (unsigned)__builtin_amdgcn_s_getreg((3 << 11) | 20) & 0xFu; }
#define XB_SPIN(cond, bar) do { unsigned _sp = 0; while (cond) { __builtin_amdgcn_s_sleep(1); \
    if ((++_sp & 255u) == 0u) { if (xb_ld(&(bar)[XB_TMO])) break; if (_sp > XB_SPIN_CAP) { atomicAdd(&(bar)[XB_TMO], 1u); break; } } } } while (0)

struct XcdBarrier {
    unsigned* bar; unsigned x;
    volatile LAS unsigned* st;
};

__device__ __forceinline__ XcdBarrier xcd_barrier_post(unsigned* bar, volatile LAS unsigned* st) {
    XcdBarrier b; b.bar = bar; b.x = xb_xcc_id(); b.st = st;
    if (threadIdx.x == 0) (void)xb_add(&bar[XB_XCNT(b.x)], 1u);
    return b;
}
__device__ __forceinline__ void xcd_barrier_complete(unsigned* bar, unsigned x, unsigned& nloc, unsigned& nx) {
    const unsigned G = gridDim.x * gridDim.y * gridDim.z;
    unsigned sum, cnt, mine, sp = 0u;
    for (;;) {
        sum = 0u; cnt = 0u; mine = 0u;
#pragma unroll
        for (unsigned j = 0; j < 16; ++j) { const unsigned c = xb_ld(&bar[XB_XCNT(j)]); sum += c; cnt += (c > 0u) ? 1u : 0u; mine = (j == x) ? c : mine; }
        if (sum == G) break;
        __builtin_amdgcn_s_sleep(1);
        if ((++sp & 255u) == 0u) { if (xb_ld(&bar[XB_TMO])) break; if (sp > XB_SPIN_CAP) { atomicAdd(&bar[XB_TMO], 1u); break; } }
    }
    nloc = mine > 0u ? mine : 1u; nx = cnt > 0u ? cnt : 1u;
}

__device__ __forceinline__ void xcd_barrier(const XcdBarrier& b) {
    asm volatile("s_waitcnt vmcnt(0)" ::: "memory");
    __syncthreads();
    if (threadIdx.x == 0) {
        unsigned* bar = b.bar;
        __builtin_amdgcn_s_waitcnt(0);
        unsigned nloc = b.st[0], nx = b.st[1];
        if (nloc == 0u) { xcd_barrier_complete(bar, b.x, nloc, nx); b.st[0] = nloc; b.st[1] = nx; }
        const unsigned old = xb_add(&bar[XB_XSUB(b.x)], 1u);
        const unsigned gen = old / nloc;
        if (old + 1u == (gen + 1u) * nloc) {
            __builtin_amdgcn_fence(__ATOMIC_RELEASE, "agent");
            asm volatile("s_waitcnt vmcnt(0)" ::: "memory");
            const unsigned og = xb_add(&bar[XB_TOP], 1u);
            const unsigned tg = og / nx;
            if (og + 1u == (tg + 1u) * nx) xb_add(&bar[XB_TOPGEN], 1u);
            else XB_SPIN(xb_ld(&bar[XB_TOPGEN]) == tg, bar);
            __builtin_amdgcn_fence(__ATOMIC_ACQUIRE, "agent");
            xb_add(&bar[XB_XGEN(b.x)], 1u);
            asm volatile("s_waitcnt vmcnt(0)" ::: "memory");
        } else {
            XB_SPIN(xb_ld(&bar[XB_XGEN(b.x)]) == gen, bar);
            __builtin_amdgcn_fence(__ATOMIC_ACQUIRE, "agent");
            asm volatile("s_waitcnt vmcnt(0)" ::: "memory");
        }
    }
    __syncthreads();
}

struct Args { const float* in[22]; float* out; unsigned char* ws; int ph_lo, ph_hi; };

struct P0Item { const float* src; size_t ld, Kd; int k0, c0, r0; bf16_t* dst; const float* gk; };
struct P0Regs { float v[32]; float gl; };
__device__ __forceinline__ void tr_load(const P0Item& p, P0Regs& r, int lane) {
    r.gl = p.gk ? p.gk[p.k0 + lane] : 1.f;
#pragma unroll
    for (int i = 0; i < 32; ++i) { const int kk = 2 * i + (lane >> 5); r.v[i] = p.src[(size_t)(p.k0 + kk) * p.ld + p.c0 + (lane & 31)]; }
}
__device__ __forceinline__ void tr_store(const P0Item& p, const P0Regs& r, LAS float* scr, int lane) {
#pragma unroll
    for (int i = 0; i < 32; ++i) { const int kk = 2 * i + (lane >> 5); scr[kk * 33 + (lane & 31)] = r.v[i] * __shfl(r.gl, kk); }
    LDS_WAIT(); asm volatile("" ::: "memory");
    const int c = lane & 7;
#pragma unroll
    for (int j = 0; j < 4; ++j) { const int n = (lane >> 3) + 8 * j; const LAS float* s = scr + (8 * c) * 33 + n;
        u32x4 o; o.x = pk2(s[0 * 33], s[1 * 33]); o.y = pk2(s[2 * 33], s[3 * 33]); o.z = pk2(s[4 * 33], s[5 * 33]); o.w = pk2(s[6 * 33], s[7 * 33]);
        *(u32x4*)(p.dst + (size_t)(p.r0 + n) * p.Kd + p.k0 + 8 * c) = o; }
    LDS_WAIT(); asm volatile("" ::: "memory");
}

constexpr int IT_FF = 5632, IT_L = 6 * IT_FF + IT_FF + 2048 + 32;
__device__ __forceinline__ P0Item p0_decode(const Args& a, unsigned char* ws, int it) {
        const int l = it / IT_L; int r = it % IT_L;
        unsigned char* wl = ws + (size_t)l * WS_WL;
        const float* src; size_t ld, Kd; int k0, c0, r0; bf16_t* dst; const float* gk = nullptr;
        if (r < 6 * IT_FF) {
            const int f = r / (3 * IT_FF), r2 = r % (3 * IT_FF), mat = r2 / IT_FF, i = r2 % IT_FF;
            if (mat < 2) { const int kb = i / 176, nb = i % 176;
                src = a.in[f ? (mat ? 20 : 19) : (mat ? 4 : 3)] + (size_t)l * D * FF; ld = FF; k0 = kb * 64; c0 = nb * 32;
                dst = (bf16_t*)(wl + (f ? W_BT2 : W_BT1)); Kd = D; r0 = (nb >> 2) * 256 + (nb & 3) * 32 + mat * 128; gk = a.in[f ? 17 : 1] + (size_t)l * D;
            } else { const int kb = i / 64, nb = i % 64;
                src = a.in[f ? 21 : 5] + (size_t)l * FF * D; ld = D; k0 = kb * 64; c0 = nb * 32;
                dst = (bf16_t*)(wl + (f ? W_WD2 : W_WD1)); Kd = FF; r0 = nb * 32; }
        } else if (r < 7 * IT_FF) {
            const int i = r - 6 * IT_FF, kb = i / 176, j = i % 176;
            src = a.in[8] + (size_t)l * D * NIN; ld = NIN; k0 = kb * 64; Kd = D; gk = a.in[6] + (size_t)l * D;
            if (j < 128) { dst = (bf16_t*)(wl + W_WIN); r0 = j * 32;
                if (j < 32) c0 = j * 32;
                else if (j < 48) c0 = 1536 + (j - 32) * 32;
                else if (j < 64) c0 = 2056 + (j - 48) * 32;
                else if (j < 96) c0 = 2568 + (j - 64) * 32;
                else c0 = 3592 + (j - 96) * 32;
            } else { dst = (bf16_t*)(wl + W_WV);
                if (j < 144) { r0 = (j - 128) * 32; c0 = 1024 + (j - 128) * 32; }
                else { r0 = 512 + (j - 144) * 32; c0 = 4616 + (j - 144) * 32; } }
        } else if (r < 7 * IT_FF + 2048) {
            const int i = r - 7 * IT_FF, kb = i / 64, nb = i % 64;
            src = a.in[16] + (size_t)l * D * D; ld = D; k0 = kb * 64; c0 = nb * 32; dst = (bf16_t*)(wl + W_WOUT); Kd = D; r0 = nb * 32;
        } else {
            const int i = r - 7 * IT_FF - 2048, g = i >> 3, kb = (i >> 2) & 1, nb = i & 3;
            src = a.in[13] + (size_t)(l * 4 + g) * 128 * 128; ld = 128; k0 = kb * 64; c0 = nb * 32; dst = (bf16_t*)(wl + W_WPOOL) + g * 128; Kd = 512; r0 = g * 128 + nb * 32;
        }
        P0Item p; p.src = src; p.ld = ld; p.Kd = Kd; p.k0 = k0; p.c0 = c0; p.r0 = r0; p.dst = dst; p.gk = gk; return p;
}
__device__ __forceinline__ void p0_weights(const Args& a, LAS unsigned char* lds, int gw, int NGW, int wave, int lane) {
    LAS float* scr = (LAS float*)(lds + wave * 8704);
    unsigned char* ws = a.ws;
    if (gw < DEPTH * IT_L) {
        P0Item pc = p0_decode(a, ws, gw); P0Regs rc; tr_load(pc, rc, lane);
        for (int it = gw; it < DEPTH * IT_L; it += NGW) {
            const int itn = it + NGW; const bool more = itn < DEPTH * IT_L;
            P0Item pn = pc; P0Regs rn = rc;
            if (more) { pn = p0_decode(a, ws, itn); tr_load(pn, rn, lane); }
            tr_store(pc, rc, scr, lane);
            pc = pn; rc = rn;
        }
    }
    const int gt = gw * 64 + lane, NT = NGW * 64;
    for (int idx = gt; idx < DEPTH * 256 * D; idx += NT) {
        const int l = idx / (256 * D), rr = (idx / D) & 255, k = idx % D;
        float v = 0.f;
        if (rr < 8) v = a.in[8][(size_t)l * D * NIN + (size_t)k * NIN + 2048 + rr];
        else if (rr < 16) v = a.in[8][(size_t)l * D * NIN + (size_t)k * NIN + 5640 + (rr - 8)];
        ((bf16_t*)(ws + (size_t)l * WS_WL + W_WIN))[(size_t)(4096 + rr) * D + k] = (bf16_t)f2bf(v * a.in[6][(size_t)l * D + k]);
    }
    for (int idx = gt; idx < DEPTH * 512 * 512; idx += NT) {
        const int l = idx / (512 * 512), rr = (idx >> 9) & 511, c = idx & 511;
        if ((rr >> 7) != (c >> 7)) ((bf16_t*)(ws + (size_t)l * WS_WL + W_WPOOL))[rr * 512 + c] = 0;
    }
}

template <bool IN_F32, bool HAS_H, bool OUT_F32>
__device__ __forceinline__ void norm_rows(const void* xin, void* xout, const bf16_t* h, const float* post_g, float wgt, float* rinv, int gw, int NGW, int lane) {
    int m = gw; if (m >= M) return;
    f32x4 nvf[IN_F32 ? 8 : 1]; u32x2 nvb[IN_F32 ? 1 : 8]; u32x2 nh[HAS_H ? 8 : 1]; float nri = 1.f;
#define NR_LOAD(mm) do { if (IN_F32) { const f32x4* xr = (const f32x4*)((const float*)xin + (size_t)(mm) * D) + lane; _Pragma("unroll") for (int j = 0; j < 8; ++j) nvf[IN_F32 ? j : 0] = xr[64 * j]; } \
        else { const u32x2* xr = (const u32x2*)((const bf16_t*)xin + (size_t)(mm) * D) + lane; _Pragma("unroll") for (int j = 0; j < 8; ++j) nvb[IN_F32 ? 0 : j] = xr[64 * j]; nri = rinv[mm]; } \
        if (HAS_H) { const u32x2* hr = (const u32x2*)(h + (size_t)(mm) * D) + lane; _Pragma("unroll") for (int j = 0; j < 8; ++j) nh[HAS_H ? j : 0] = hr[64 * j]; } } while (0)
    NR_LOAD(m);
    for (; m < M; m += NGW) {
        f32x4 v[8]; u32x2 hw[8];
        const float ri = nri;
#pragma unroll
        for (int j = 0; j < 8; ++j) {
            if (IN_F32) v[j] = nvf[IN_F32 ? j : 0]; else { const u32x2 w = nvb[IN_F32 ? 0 : j]; v[j] = (f32x4){bflo(w.x), bfhi(w.x), bflo(w.y), bfhi(w.y)} * ri; }
            if (HAS_H) hw[j] = nh[HAS_H ? j : 0]; }
        const int mn = m + NGW;
        if (mn < M) NR_LOAD(mn);
        if (HAS_H) {
            f32x4 hv[8]; float s = 0.f;
#pragma unroll
            for (int j = 0; j < 8; ++j) { const u32x2 w = hw[j]; hv[j] = (f32x4){bflo(w.x), bfhi(w.x), bflo(w.y), bfhi(w.y)};
                s += (hv[j][0] * hv[j][0] + hv[j][1] * hv[j][1]) + (hv[j][2] * hv[j][2] + hv[j][3] * hv[j][3]); }
            const float r = rsqrtf(wave_sum(s) * (1.f / D) + EPS) * wgt;
#pragma unroll
            for (int j = 0; j < 8; ++j) { const f32x4 g = ((const f32x4*)post_g)[64 * j + lane]; v[j] = v[j] + hv[j] * r * g; }
        }
        if (OUT_F32) { f32x4* xo = (f32x4*)((float*)xout + (size_t)m * D) + lane;
#pragma unroll
            for (int j = 0; j < 8; ++j) xo[64 * j] = v[j];
        } else {
            float s2 = 0.f;
#pragma unroll
            for (int j = 0; j < 8; ++j) s2 += (v[j][0] * v[j][0] + v[j][1] * v[j][1]) + (v[j][2] * v[j][2] + v[j][3] * v[j][3]);
            const float ms = wave_sum(s2) * (1.f / D) + EPS, r2 = rsqrtf(ms);
            if (lane == 0) rinv[m] = sqrtf(ms);
            u32x2* o8 = (u32x2*)((bf16_t*)xout + (size_t)m * D) + lane;
#pragma unroll
            for (int j = 0; j < 8; ++j) { const f32x4 y = v[j] * r2; u32x2 w; w.x = pk2(y[0], y[1]); w.y = pk2(y[2], y[3]); o8[64 * j] = w; }
        }
    }
#undef NR_LOAD
}

__device__ __forceinline__ void unpack8(const u32x4 w, float* f) { f[0] = bflo(w.x); f[1] = bfhi(w.x); f[2] = bflo(w.y); f[3] = bfhi(w.y); f[4] = bflo(w.z); f[5] = bfhi(w.z); f[6] = bflo(w.w); f[7] = bfhi(w.w); }
__device__ __forceinline__ float logsig(float x) { return fminf(x, 0.f) - log1pf(expf(-fabsf(x))); }
__device__ __forceinline__ void prep_phase(const Args& a, int l, LAS unsigned char* lds) {
    unsigned char* ws = a.ws;
    const bf16_t* P = (const bf16_t*)(ws + WS_P);
    bf16_t* QK = (bf16_t*)(ws + WS_QK); bf16_t* DP = (bf16_t*)(ws + WS_DPOOL);
    const float* conv = a.in[9] + (size_t)l * 4 * 1024;
    const int tid0 = mytid(); const int gt = blockIdx.x * NTHR + tid0, NT = gridDim.x * NTHR;
    for (int idx = gt; idx < (M / 16) * 128; idx += NT) {
        const int c8 = (idx & 127) * 8, tok0 = (idx >> 7) * 16; const bool head = ((tok0 & (SEQ - 1)) == 0);
        u32x4 rows[19];
#pragma unroll
        for (int i = 0; i < 19; ++i) { const bool valid = (i >= 3) || !head; const int r = valid ? tok0 - 3 + i : tok0;
            const u32x4 w = *(const u32x4*)(P + (size_t)r * LDP + c8); rows[i] = valid ? w : (u32x4){0u, 0u, 0u, 0u}; }
        float wj[4][8];
#pragma unroll
        for (int j = 0; j < 4; ++j) { const f32x4 w0 = *(const f32x4*)(conv + j * 1024 + c8), w1 = *(const f32x4*)(conv + j * 1024 + c8 + 4);
#pragma unroll
            for (int e = 0; e < 4; ++e) { wj[j][e] = w0[e]; wj[j][4 + e] = w1[e]; } }
#pragma unroll
        for (int tt = 0; tt < 16; ++tt) {
            float acc[8];
#pragma unroll
            for (int e = 0; e < 8; ++e) acc[e] = 0.f;
#pragma unroll
            for (int j = 0; j < 4; ++j) { float u[8]; unpack8(rows[tt + 3 - j], u);
#pragma unroll
                for (int e = 0; e < 8; ++e) acc[e] += u[e] * wj[j][e]; }
#pragma unroll
            for (int e = 0; e < 8; ++e) acc[e] = acc[e] / (1.f + __expf(-acc[e]));
            u32x4 o; o.x = pk2(acc[0], acc[1]); o.y = pk2(acc[2], acc[3]); o.z = pk2(acc[4], acc[5]); o.w = pk2(acc[6], acc[7]);
            *(u32x4*)(QK + (size_t)(tok0 + tt) * 1024 + c8) = o;
        }
    }
    for (int idx = gt; idx < M * 64; idx += NT) {
        const int ln = idx & 63, widx = idx >> 6, g = __builtin_amdgcn_readfirstlane(widx & 3), tok = (widx >> 2) * 4 + (ln >> 4), c8 = g * 128 + (ln & 15) * 8, t = tok & (SEQ - 1);
        const int win = 2 << g, n = (t + 1 < win) ? (t + 1) : win;
        float acc[8], u0[8];
        { const u32x4 w = *(const u32x4*)(P + (size_t)tok * LDP + 1536 + c8); unpack8(w, u0); }
#pragma unroll
        for (int e = 0; e < 8; ++e) acc[e] = u0[e];
#define POOL_TAPS(W) do { u32x4 rw[W - 1]; _Pragma("unroll") for (int j = 1; j < W; ++j) { const int r = (j < n) ? tok - j : tok; rw[j - 1] = *(const u32x4*)(P + (size_t)r * LDP + 1536 + c8); } \
            _Pragma("unroll") for (int j = 1; j < W; ++j) { float u[8]; unpack8(rw[j - 1], u); const float mk = (j < n) ? 1.f : 0.f; _Pragma("unroll") for (int e = 0; e < 8; ++e) acc[e] += u[e] * mk; } } while (0)
        if (g == 0) POOL_TAPS(2); else if (g == 1) POOL_TAPS(4); else if (g == 2) POOL_TAPS(8); else POOL_TAPS(16);
#undef POOL_TAPS
        const float inv = 1.f / (float)n;
#pragma unroll
        for (int e = 0; e < 8; ++e) acc[e] = acc[e] * inv - u0[e];
        u32x4 o; o.x = pk2(acc[0], acc[1]); o.y = pk2(acc[2], acc[3]); o.z = pk2(acc[4], acc[5]); o.w = pk2(acc[6], acc[7]);
        *(u32x4*)(DP + (size_t)tok * 512 + c8) = o;
    }
    {   unsigned* kn = (unsigned*)(ws + WS_BAR) + 3968 + 32 * l;
        for (int idx = gt; idx < M * 8; idx += NT) {
            const int tok = idx >> 3, h = idx & 7; const bf16_t* kp = P + (size_t)tok * LDP + 3072 + h * 128; float ss = 0.f;
#pragma unroll
            for (int c = 0; c < 16; ++c) { const u32x4 w = *(const u32x4*)(kp + c * 8); float u[8]; unpack8(w, u);
#pragma unroll
                for (int e = 0; e < 8; ++e) ss += u[e] * u[e]; }
            ss = fmaxf(ss, __shfl_xor(ss, 8)); ss = fmaxf(ss, __shfl_xor(ss, 16)); ss = fmaxf(ss, __shfl_xor(ss, 32));
            if ((tid0 & 63) < 8) atomicMax(&kn[(tok >> 12) * 8 + h], __float_as_uint(ss));
        }
    }
    if (blockIdx.x < NB * 12) {
        const int seq = blockIdx.x, b = seq / 12, hh = seq % 12, tid = tid0, lane = tid & 63, wv = tid >> 6;
        const float* G = (const float*)(ws + WS_GATES);
        float* rowb = (float*)(ws + WS_ROWB) + (size_t)seq * SEQ; float* colb = (float*)(ws + WS_COLB) + (size_t)seq * SEQ;
        const float bi = (hh < 4) ? a.in[10][l * 4 + hh] : 0.f;
        const float bf = (hh < 4) ? a.in[11][l * 4 + hh] : a.in[15][l * 8 + (hh - 4)];
        const int gi = (hh < 4) ? hh : 0, gf = (hh < 4) ? 4 + hh : 8 + (hh - 4);
        double loc[8]; float iv[8]; double run = 0.0;
#pragma unroll
        for (int e = 0; e < 8; ++e) { const float* g = G + (size_t)(b * SEQ + tid * 8 + e) * 16;
            iv[e] = g[gi] + bi; run += (double)logsig(g[gf] + bf); loc[e] = run; }
        double incl = run;
#pragma unroll
        for (int o = 1; o < 64; o <<= 1) { const double t2 = __shfl_up(incl, o); if (lane >= o) incl += t2; }
        LAS double* sh = (LAS double*)lds;
        __syncthreads();
        if (lane == 63) sh[wv] = incl;
        __syncthreads();
        double off = incl - run;
        for (int w2 = 0; w2 < wv; ++w2) off += sh[w2];
        float cb[8]; float tmax = -INFINITY;
#pragma unroll
        for (int e = 0; e < 8; ++e) { const double c = loc[e] + off; const int pos = tid * 8 + e;
            rowb[pos] = (float)(c * (double)LOG2E);
            cb[e] = (hh < 4) ? (float)(((double)iv[e] - c) * (double)LOG2E) : (float)(-c * (double)LOG2E); tmax = fmaxf(tmax, cb[e]); }
        if (hh < 4) {
            tmax = fmaxf(tmax, __shfl_xor(tmax, 1)); tmax = fmaxf(tmax, __shfl_xor(tmax, 2)); tmax = fmaxf(tmax, __shfl_xor(tmax, 4));
#pragma unroll
            for (int e = 0; e < 8; ++e) colb[tid * 8 + e] = exp2f(cb[e] - tmax);
            if ((tid & 7) == 0) ((float*)(ws + WS_CMAXT))[(size_t)seq * 64 + (tid >> 3)] = tmax;
        } else {
#pragma unroll
            for (int e = 0; e < 8; ++e) colb[tid * 8 + e] = cb[e];
        }
        __syncthreads();
    }
}

constexpr int AT_SLOT = 16384, AT_NK = 4, AT_NV = 4, AT_KOFF = 0, AT_VOFF = AT_NK * AT_SLOT, AT_COFF = AT_VOFF + AT_NV * AT_SLOT, AT_CMOFF = AT_COFF + 16384;
constexpr float AT_THR = 8.f;
#define MFMA32(a, b, c) __builtin_amdgcn_mfma_f32_32x32x16_bf16((a), (b), (c), 0, 0, 0)
#define AT_SB() __builtin_amdgcn_sched_barrier(0)

struct AttnSt { bf16x8 qf[8]; f32x16 o[4]; bf16x8 pbp[4]; float m, lsum; };

template <int MODE, bool DO_QK, bool DO_SM, bool DO_PV, bool MASK, bool DO_LD, bool LAST>
__device__ __forceinline__ void attn_body(AttnSt& st, LAS unsigned char* lds, int i, int v3, int nt, const bf16_t* __restrict__ kgp, int pitch, const bf16_t* __restrict__ vgp,
                                          float rb, unsigned kbase, unsigned vbase, int wofs, int hi, int qi) {
    if (DO_LD) {
        const int tK = nt - 1 - ((i + 3 < nt) ? i + 3 : nt - 1), tV = nt - 1 - ((i + 2 < nt) ? i + 2 : nt - 1);
        const bf16_t* gk = kgp + (size_t)(tK * 64) * pitch; const bf16_t* gv = vgp + tV * 64;
        LAS unsigned char* dk = lds + AT_KOFF + ((i + 3) & 3) * AT_SLOT + wofs; LAS unsigned char* dv = lds + AT_VOFF + ((i + 2) & 3) * AT_SLOT + wofs;
        __builtin_amdgcn_global_load_lds((const unsigned*)gk, (LAS unsigned*)dk, 16, 0, 0);
        __builtin_amdgcn_global_load_lds((const unsigned*)(gk + (size_t)32 * pitch), (LAS unsigned*)(dk + 8192), 16, 0, 0);
        __builtin_amdgcn_global_load_lds((const unsigned*)gv, (LAS unsigned*)dv, 16, 0, 0);
        __builtin_amdgcn_global_load_lds((const unsigned*)(gv + (size_t)64 * M), (LAS unsigned*)(dv + 8192), 16, 0, 0);
    }
    LAS const unsigned char* Kb = lds + AT_KOFF + (i & 3) * AT_SLOT;
    LAS const unsigned char* Vb = lds + AT_VOFF + ((i - 1) & 3) * AT_SLOT;
    const int k0 = (nt - 1 - i) * 64;
    LAS const unsigned char* Cb = lds + AT_COFF + (k0 + 8 * hi) * 4;
    f32x16 sn0, sn1;
    bf16x8 fa[4], fb[4];
#define AT_KLD(F, b) do { F[0] = *(LAS const bf16x8*)(Kb + (kbase ^ ((2 * (b)) << 5))); F[1] = *(LAS const bf16x8*)(Kb + 8192 + (kbase ^ ((2 * (b)) << 5))); \
                          F[2] = *(LAS const bf16x8*)(Kb + (kbase ^ ((2 * (b) + 1) << 5))); F[3] = *(LAS const bf16x8*)(Kb + 8192 + (kbase ^ ((2 * (b) + 1) << 5))); } while (0)
#define AT_KMM(F, b) do { sn0 = MFMA32(F[0], st.qf[2 * (b)], sn0); sn1 = MFMA32(F[1], st.qf[2 * (b)], sn1); sn0 = MFMA32(F[2], st.qf[2 * (b) + 1], sn0); sn1 = MFMA32(F[3], st.qf[2 * (b) + 1], sn1); } while (0)
#define AT_VLD(F, g) do { _Pragma("unroll") for (int d_ = 0; d_ < 4; ++d_) F[d_] = *(LAS const bf16x8*)(Vb + d_ * 4096 + (vbase ^ ((g) << 5))); } while (0)
#define AT_VMM(F, g) do { _Pragma("unroll") for (int d_ = 0; d_ < 4; ++d_) st.o[d_] = MFMA32(F[d_], st.pbp[g], st.o[d_]); } while (0)
    if (DO_QK) {
#pragma unroll
        for (int r = 0; r < 16; ++r) { sn0[r] = 0.f; sn1[r] = 0.f; }
        AT_KLD(fa, 0); AT_SB();
        AT_KLD(fb, 1); AT_KMM(fa, 0); AT_SB();
        AT_KLD(fa, 2); AT_KMM(fb, 1); AT_SB();
        AT_KLD(fb, 3); AT_KMM(fa, 2); AT_SB();
        if (DO_PV) AT_VLD(fa, 0);
        AT_KMM(fb, 3); AT_SB();
    } else if (DO_PV) { AT_VLD(fa, 0); AT_SB(); }
    float alpha = 1.f, mn = 0.f, mx = 0.f, ps = 0.f, rowfac = 0.f; bool need = false;
    f32x16& z0 = sn0; f32x16& z1 = sn1;
    if (DO_PV) { AT_VLD(fb, 1); AT_VMM(fa, 0); }
    if (DO_SM) {
        if (MODE == 0) {
#pragma unroll
            for (int h2 = 0; h2 < 2; ++h2) {
                const f32x4 c0a = *(LAS const f32x4*)(Cb + (16 * h2) * 4), c0b = *(LAS const f32x4*)(Cb + (16 * h2 + 4) * 4);
                const f32x4 c1a = *(LAS const f32x4*)(Cb + (32 + 16 * h2) * 4), c1b = *(LAS const f32x4*)(Cb + (32 + 16 * h2 + 4) * 4);
#pragma unroll
                for (int e = 0; e < 4; ++e) {
                    z0[8 * h2 + e] = fmaf(z0[8 * h2 + e], QSCALE * LOG2E, c0a[e]); z0[8 * h2 + 4 + e] = fmaf(z0[8 * h2 + 4 + e], QSCALE * LOG2E, c0b[e]);
                    z1[8 * h2 + e] = fmaf(z1[8 * h2 + e], QSCALE * LOG2E, c1a[e]); z1[8 * h2 + 4 + e] = fmaf(z1[8 * h2 + 4 + e], QSCALE * LOG2E, c1b[e]); }
            }
            if (MASK) {
#pragma unroll
                for (int r = 0; r < 16; ++r) { const int key = k0 + 16 * (r >> 3) + 8 * hi + (r & 7);
                    if (key > qi) z0[r] = -INFINITY;
                    if (key + 32 > qi) z1[r] = -INFINITY; }
            }
            mx = fmaxf(z0[0], z1[0]);
#pragma unroll
            for (int r = 1; r < 16; ++r) mx = fmaxf(mx, fmaxf(z0[r], z1[r]));
            { auto rr = __builtin_amdgcn_permlane32_swap(__float_as_uint(mx), __float_as_uint(mx), false, false); mx = fmaxf(__uint_as_float(rr[0]), __uint_as_float(rr[1])); }
        } else {
            mx = rb + *(LAS const float*)(lds + AT_CMOFF + (nt - 1 - i) * 4);
        }
        need = !__all(mx <= st.m + AT_THR);
        mn = need ? fmaxf(st.m, mx) : st.m;
        alpha = need ? __builtin_amdgcn_exp2f(st.m - mn) : 1.f; st.m = mn;
        if (MODE == 1) rowfac = QSCALE * __builtin_amdgcn_exp2f(mx - mn);
    }
    AT_SB();
    if (DO_PV) { AT_VLD(fa, 2); AT_VMM(fb, 1); }
    if (DO_SM) {
        if (MODE == 0) {
#pragma unroll
            for (int r = 0; r < 16; ++r) { const float p0 = __builtin_amdgcn_exp2f(z0[r] - mn); z0[r] = p0; ps += p0; }
        } else {
#pragma unroll
            for (int h2 = 0; h2 < 2; ++h2) { const f32x4 ca = *(LAS const f32x4*)(Cb + (16 * h2) * 4), cb4 = *(LAS const f32x4*)(Cb + (16 * h2 + 4) * 4);
#pragma unroll
                for (int e = 0; e < 8; ++e) { const int r = 8 * h2 + e; float p0 = z0[r] * ((e < 4 ? ca[e & 3] : cb4[e & 3]) * rowfac);
                    if (MASK) { if (k0 + 16 * h2 + 8 * hi + e > qi) p0 = 0.f; }
                    z0[r] = p0; ps += p0; } }
        }
    }
    AT_SB();
    if (DO_PV) { AT_VLD(fb, 3); AT_VMM(fa, 2); }
    if (DO_SM) {
        if (MODE == 0) {
#pragma unroll
            for (int r = 0; r < 16; ++r) { const float p1 = __builtin_amdgcn_exp2f(z1[r] - mn); z1[r] = p1; ps += p1; }
        } else {
#pragma unroll
            for (int h2 = 0; h2 < 2; ++h2) { const f32x4 ca = *(LAS const f32x4*)(Cb + (32 + 16 * h2) * 4), cb4 = *(LAS const f32x4*)(Cb + (32 + 16 * h2 + 4) * 4);
#pragma unroll
                for (int e = 0; e < 8; ++e) { const int r = 8 * h2 + e; float p1 = z1[r] * ((e < 4 ? ca[e & 3] : cb4[e & 3]) * rowfac);
                    if (MASK) { if (k0 + 32 + 16 * h2 + 8 * hi + e > qi) p1 = 0.f; }
                    z1[r] = p1; ps += p1; } }
        }
    }
    AT_SB();
    if (DO_PV) { AT_VMM(fb, 3); AT_SB(); }
    if (DO_SM) {
        st.lsum = st.lsum * alpha + ps;
#pragma unroll
        for (int j = 0; j < 2; ++j) {
            u32x4 w0 = {cvtpk(z0[8 * j + 0], z0[8 * j + 1]), cvtpk(z0[8 * j + 2], z0[8 * j + 3]), cvtpk(z0[8 * j + 4], z0[8 * j + 5]), cvtpk(z0[8 * j + 6], z0[8 * j + 7])};
            u32x4 w1 = {cvtpk(z1[8 * j + 0], z1[8 * j + 1]), cvtpk(z1[8 * j + 2], z1[8 * j + 3]), cvtpk(z1[8 * j + 4], z1[8 * j + 5]), cvtpk(z1[8 * j + 6], z1[8 * j + 7])};
            st.pbp[j] = __builtin_bit_cast(bf16x8, w0); st.pbp[2 + j] = __builtin_bit_cast(bf16x8, w1);
        }
        if (need) {
#pragma unroll
            for (int d = 0; d < 4; ++d)
#pragma unroll
                for (int r = 0; r < 16; ++r) st.o[d][r] *= alpha;
        }
    }
    if (LAST) asm volatile("s_waitcnt vmcnt(0) lgkmcnt(0)" ::: "memory"); else asm volatile("s_waitcnt vmcnt(8) lgkmcnt(0)" ::: "memory");
    __builtin_amdgcn_s_barrier();
#undef AT_KLD
#undef AT_KMM
#undef AT_VLD
#undef AT_VMM
}

template <int MODE>
__device__ __forceinline__ void attn_unit(LAS unsigned char* lds, const bf16_t* __restrict__ Q, const bf16_t* __restrict__ K, int pitch, const bf16_t* __restrict__ Vt,
                                          const float* __restrict__ rowb, const float* __restrict__ colb, const float* __restrict__ cmaxt, bf16_t* O, const bf16_t* MO, const float* hg, int qb, float kn2) {
    const int tid = mytid(), w = __builtin_amdgcn_readfirstlane(tid >> 6), lane = tid & 63, q32 = lane & 31, hi = lane >> 5;
    const int r0 = qb * 256 + w * 32, qi = r0 + q32;
    AttnSt st;
#pragma unroll
    for (int db = 0; db < 8; ++db) st.qf[db] = *(const bf16x8*)(Q + (size_t)qi * pitch + db * 16 + hi * 8);
    const float rb = rowb[qi], cref = rowb[qb * 256];
    const int nt = 4 * (qb + 1);
    const int kr = 4 * w + (lane >> 4), krow = (kr & ~15) | ((kr & 4) << 1) | ((kr & 8) >> 1) | (kr & 3), kch = (lane & 15) ^ (kr & 15);
    const bf16_t* kgp = K + (size_t)krow * pitch + kch * 8;
    const int vr = 8 * w + (lane >> 3), vgr = (lane & 7) ^ ((vr >> 1) & 7);
    const bf16_t* vgp = Vt + (size_t)vr * M + vgr * 8;
    const int wofs = w * 1024;
    const int x = q32 & 15, y = (q32 >> 1) & 7;
    const unsigned kbase = q32 * 256 + ((hi ^ (x & 1)) << 4) + ((x >> 1) << 5);
    const unsigned vbase = q32 * 128 + ((hi ^ (y & 1)) << 4) + ((y >> 1) << 5);
    st.m = -1e30f; st.lsum = 0.f;
#pragma unroll
    for (int d = 0; d < 4; ++d)
#pragma unroll
        for (int r = 0; r < 16; ++r) st.o[d][r] = 0.f;
    {
        const bf16_t* gk0 = kgp + (size_t)((nt - 1) * 64) * pitch; const bf16_t* gk1 = kgp + (size_t)((nt - 2) * 64) * pitch; const bf16_t* gv0 = vgp + (nt - 1) * 64;
        LAS unsigned char* dk = lds + AT_KOFF + wofs; LAS unsigned char* dv = lds + AT_VOFF + wofs;
        __builtin_amdgcn_global_load_lds((const unsigned*)gk0, (LAS unsigned*)dk, 16, 0, 0);
        __builtin_amdgcn_global_load_lds((const unsigned*)(gk0 + (size_t)32 * pitch), (LAS unsigned*)(dk + 8192), 16, 0, 0);
        __builtin_amdgcn_global_load_lds((const unsigned*)gk1, (LAS unsigned*)(dk + AT_SLOT), 16, 0, 0);
        __builtin_amdgcn_global_load_lds((const unsigned*)(gk1 + (size_t)32 * pitch), (LAS unsigned*)(dk + AT_SLOT + 8192), 16, 0, 0);
        __builtin_amdgcn_global_load_lds((const unsigned*)gv0, (LAS unsigned*)dv, 16, 0, 0);
        __builtin_amdgcn_global_load_lds((const unsigned*)(gv0 + (size_t)64 * M), (LAS unsigned*)(dv + 8192), 16, 0, 0);
        { const bf16_t* gk2 = kgp + (size_t)((nt - 3) * 64) * pitch; const bf16_t* gv1 = vgp + (nt - 2) * 64;
          __builtin_amdgcn_global_load_lds((const unsigned*)gk2, (LAS unsigned*)(dk + 2 * AT_SLOT), 16, 0, 0);
          __builtin_amdgcn_global_load_lds((const unsigned*)(gk2 + (size_t)32 * pitch), (LAS unsigned*)(dk + 2 * AT_SLOT + 8192), 16, 0, 0);
          __builtin_amdgcn_global_load_lds((const unsigned*)gv1, (LAS unsigned*)(dv + AT_SLOT), 16, 0, 0);
          __builtin_amdgcn_global_load_lds((const unsigned*)(gv1 + (size_t)64 * M), (LAS unsigned*)(dv + AT_SLOT + 8192), 16, 0, 0); }
        for (int idx = tid; idx < nt * 16; idx += NTHR) { f32x4 c4 = *(const f32x4*)(colb + idx * 4); if (MODE == 0) c4 = c4 + cref; *(LAS f32x4*)(lds + AT_COFF + idx * 16) = c4; }
        if (MODE == 1) { if (tid < nt) *(LAS float*)(lds + AT_CMOFF + tid * 4) = cmaxt[tid]; }
        asm volatile("s_waitcnt vmcnt(0) lgkmcnt(0)" ::: "memory");
        __builtin_amdgcn_s_barrier();
    }
#define AT_ARGS lds, i, v3, nt, kgp, pitch, vgp, rb, kbase, vbase, wofs, hi, qi
    int v3 = 0;
    { const int i = 0; attn_body<MODE, true, true, false, true, true, false>(st, AT_ARGS); v3 = 1; }
    for (int i = 1; i <= 3; ++i) { attn_body<MODE, true, true, true, true, true, false>(st, AT_ARGS); v3 = (v3 == 2) ? 0 : v3 + 1; }
    int i_end = nt;
    if (MODE == 0) {
        float q2 = 0.f;
#pragma unroll
        for (int db = 0; db < 8; ++db) { const u32x4 w = __builtin_bit_cast(u32x4, st.qf[db]); float u[8]; unpack8(w, u);
#pragma unroll
            for (int e = 0; e < 8; ++e) q2 += u[e] * u[e]; }
        { auto rr = __builtin_amdgcn_permlane32_swap(__float_as_uint(q2), __float_as_uint(q2), false, false); q2 = __uint_as_float(rr[0]) + __uint_as_float(rr[1]); }
        float mlo = st.m;
#pragma unroll
        for (int o = 1; o < 32; o <<= 1) { q2 = fmaxf(q2, __shfl_xor(q2, o)); mlo = fminf(mlo, __shfl_xor(mlo, o)); }
        LAS float* ex = (LAS float*)(lds + AT_CMOFF + 256);
        if (lane == 0) { ex[2 * w] = q2; ex[2 * w + 1] = mlo; }
        asm volatile("s_waitcnt lgkmcnt(0)" ::: "memory");
        __builtin_amdgcn_s_barrier();
        float q2u = ex[0], mlu = ex[1];
#pragma unroll
        for (int j = 1; j < 8; ++j) { q2u = fmaxf(q2u, ex[2 * j]); mlu = fminf(mlu, ex[2 * j + 1]); }
        const float sb = sqrtf(q2u * kn2) * (QSCALE * LOG2E) * 1.001f;
        const int ic = 4 + lane;
        bool dead = false;
        if (ic <= nt - 1) { const float ctop = *(LAS const float*)(lds + AT_COFF + ((nt - 1 - ic) * 64 + 63) * 4); dead = (sb + ctop - mlu) < -160.f; }
        const unsigned long long bal = __ballot(dead);
        if (bal) i_end = 4 + (int)__builtin_ctzll(bal);
    }
    for (int i = 4; i <= i_end - 1; ++i) { attn_body<MODE, true, true, true, false, true, false>(st, AT_ARGS); v3 = (v3 == 2) ? 0 : v3 + 1; }
    { const int i = i_end; attn_body<MODE, false, false, true, false, false, true>(st, AT_ARGS); }
#undef AT_ARGS
    float ltot;
    { auto rr = __builtin_amdgcn_permlane32_swap(__float_as_uint(st.lsum), __float_as_uint(st.lsum), false, false); ltot = __uint_as_float(rr[0]) + __uint_as_float(rr[1]); }
    float inv;
    if (MODE == 0) inv = 1.f / ltot;
    else {
        inv = 1.f / fmaxf(fabsf(ltot), __builtin_amdgcn_exp2f(-st.m));
        float ss = 0.f;
#pragma unroll
        for (int d = 0; d < 4; ++d)
#pragma unroll
            for (int r = 0; r < 16; ++r) { const float hv = st.o[d][r] * inv; ss += hv * hv; }
        { auto rr = __builtin_amdgcn_permlane32_swap(__float_as_uint(ss), __float_as_uint(ss), false, false); ss = __uint_as_float(rr[0]) + __uint_as_float(rr[1]); }
        inv *= rsqrtf(ss * (1.f / 128.f) + EPS);
    }
#pragma unroll
    for (int dbk = 0; dbk < 4; ++dbk)
#pragma unroll
        for (int g = 0; g < 4; ++g) {
            const int d = dbk * 32 + 8 * g + 4 * hi;
            float v0 = st.o[dbk][4 * g + 0] * inv, v1 = st.o[dbk][4 * g + 1] * inv, v2 = st.o[dbk][4 * g + 2] * inv, v3o = st.o[dbk][4 * g + 3] * inv;
            if (MODE == 1) {
                const f32x4 gg = *(const f32x4*)(hg + d); const u32x2 mo = *(const u32x2*)(MO + (size_t)qi * LDP + d);
                v0 *= gg[0] / (1.f + __expf(-bflo(mo.x))); v1 *= gg[1] / (1.f + __expf(-bfhi(mo.x)));
                v2 *= gg[2] / (1.f + __expf(-bflo(mo.y))); v3o *= gg[3] / (1.f + __expf(-bfhi(mo.y)));
            }
            u32x2 wv; wv.x = cvtpk(v0, v1); wv.y = cvtpk(v2, v3o);
            *(u32x2*)(O + (size_t)qi * D + d) = wv;
        }
}

__device__ __forceinline__ void attn_dispatch(const Args& a, int l, LAS unsigned char* lds, int bh, int qb) {
    unsigned char* ws = a.ws;
    const bf16_t* P = (const bf16_t*)(ws + WS_P); const bf16_t* QK = (const bf16_t*)(ws + WS_QK); const bf16_t* VT = (const bf16_t*)(ws + WS_VT);
    const float* rowb = (const float*)(ws + WS_ROWB); const float* colb = (const float*)(ws + WS_COLB); const float* cmaxt = (const float*)(ws + WS_CMAXT);
    bf16_t* CAT = (bf16_t*)(ws + WS_CAT);
    if (bh < 32) { const int b = bh >> 3, h = bh & 7; const size_t tok0 = (size_t)b * SEQ;
        attn_unit<0>(lds, P + tok0 * LDP + 2048 + h * 128, P + tok0 * LDP + 3072 + h * 128, LDP, VT + (size_t)(512 + h * 128) * M + tok0,
                     rowb + (size_t)(b * 12 + 4 + h) * SEQ, colb + (size_t)(b * 12 + 4 + h) * SEQ, nullptr, CAT + tok0 * D + 1024 + h * 128, nullptr, nullptr, qb,
                     __uint_as_float(((const unsigned*)(ws + WS_BAR))[3968 + 32 * l + b * 8 + h]));
    } else { const int b2 = (bh - 32) >> 2, h = (bh - 32) & 3; const size_t tok0 = (size_t)b2 * SEQ;
        attn_unit<1>(lds, QK + tok0 * 1024 + h * 128, QK + tok0 * 1024 + 512 + h * 128, 1024, VT + (size_t)(h * 128) * M + tok0,
                     rowb + (size_t)(b2 * 12 + h) * SEQ, colb + (size_t)(b2 * 12 + h) * SEQ, cmaxt + (size_t)(b2 * 12 + h) * 64, CAT + tok0 * D + h * 128, P + tok0 * LDP + 1024 + h * 128,
                     a.in[12] + (size_t)l * 512 + h * 128, qb, 0.f);
    }
}

__global__ void __launch_bounds__(NTHR, 2) mega_fwd(Args a) {
    extern __shared__ __attribute__((aligned(16))) unsigned char lds_raw[];
    LAS unsigned char* lds = (LAS unsigned char*)lds_raw;
    const int G = gridDim.x, NGW = G * NWAVES;
    unsigned char* ws = a.ws;
    if (threadIdx.x < 64) ((LAS unsigned*)(lds + 151552))[threadIdx.x] = 0u;
    __syncthreads();
#if MK_COOP
    XcdBarrier bar; bar.bar = (unsigned*)(ws + WS_BAR); bar.x = xb_xcc_id(); bar.st = (volatile LAS unsigned*)(lds + 151552);
    if (blockIdx.x == 0) for (int i = threadIdx.x; i < (int)(BAR_BYTES / 4); i += NTHR) bar.bar[i] = 0u;
#else
    const XcdBarrier bar = xcd_barrier_post((unsigned*)(ws + WS_BAR), (volatile LAS unsigned*)(lds + 151552));
#endif
    bf16_t* XN = (bf16_t*)(ws + WS_XN); float* RINV = (float*)(ws + WS_RINV);
    for (int ph = a.ph_lo; ph < a.ph_hi; ++ph) {
        const int tid = mytid(), lane = tid & 63, wave = __builtin_amdgcn_readfirstlane(tid >> 6);
        const int gw = blockIdx.x * NWAVES + wave;
        if (ph == 0) {
#ifndef NO_P0
            p0_weights(a, lds, gw, NGW, wave, lane);
#endif
            norm_rows<true, false, false>(a.in[0], XN, nullptr, nullptr, 0.f, RINV, gw, NGW, lane);
        } else {
            const int l = (ph - 1) / 11, s = (ph - 1) % 11;
            unsigned char* wl = ws + (size_t)l * WS_WL;
            if (s == 0 || s == 8) {
                pg8::Gemm g{XN, (const bf16_t*)(wl + (s == 0 ? W_BT1 : W_BT2)), M, 2 * FF, D}; pg8::StaticOrder S; S.init(M, 2 * FF, G, (int)blockIdx.x);
                pg8::EpiSwiglu E{(bf16_t*)(ws + WS_BIG), FF};
                pg8::gemm_phase<pg8::EpiSwiglu, pg8::StaticOrder, true, true>(lds, g, S, E);
            } else if (s == 1 || s == 9 || s == 6) {
                pg8::Gemm g{}; g.M = M; g.N = D;
                if (s == 6) { g.A = (const bf16_t*)(ws + WS_CAT); g.Bt = (const bf16_t*)(wl + W_WOUT); g.K = D; }
                else { g.A = (const bf16_t*)(ws + WS_BIG); g.Bt = (const bf16_t*)(wl + (s == 1 ? W_WD1 : W_WD2)); g.K = FF; }
                pg8::StaticOrder S; S.init(M, D, G, (int)blockIdx.x);
                pg8::EpiStore E{(bf16_t*)(ws + (s == 6 ? WS_H_MIX : WS_H_FFN)), D};
                pg8::gemm_phase<pg8::EpiStore, pg8::StaticOrder, true, true>(lds, g, S, E);
            } else if (s == 2 || s == 7 || s == 10) {
                const float* post_g = a.in[s == 2 ? 2 : (s == 7 ? 7 : 18)] + (size_t)l * D;
                const float wgt = (s == 7) ? 1.f : 0.5f;
                const bool wx = !(s == 10 && l == DEPTH - 1);
                const bf16_t* Hh = (const bf16_t*)(ws + (s == 7 ? WS_H_MIX : WS_H_FFN));
                if (wx) norm_rows<false, true, false>(XN, XN, Hh, post_g, wgt, RINV, gw, NGW, lane);
                else norm_rows<false, true, true>(XN, a.out, Hh, post_g, wgt, RINV, gw, NGW, lane);
            } else if (s == 3) {
                pg8::Gemm g{XN, (const bf16_t*)(wl + W_WIN), M, NP, D, (const bf16_t*)(wl + W_WV), XN}; pg8::DualOrder S; S.init(M, NP, NV, M, G, (int)blockIdx.x);
                pg8::EpiWinDual E{pg8::EpiWin{(bf16_t*)(ws + WS_P), LDP, (float*)(ws + WS_GATES), GATE_PN}, pg8::EpiStore{(bf16_t*)(ws + WS_VT), M}};
                pg8::gemm_phase<pg8::EpiWinDual, pg8::DualOrder, true, true>(lds, g, S, E);
            } else if (s == 4) {
#ifndef NO_PREP
                prep_phase(a, l, lds);
#endif
            } else if (s == 5) {
                { pg8::Gemm g{(const bf16_t*)(ws + WS_DPOOL), (const bf16_t*)(wl + W_WPOOL), M, 512, 512}; pg8::StaticOrder S; S.init(M, 512, G, (int)blockIdx.x);
                  pg8::EpiPool E{(bf16_t*)(ws + WS_CAT) + 512, D, a.in[14] + (size_t)l * 512};
                  pg8::gemm_phase<pg8::EpiPool, pg8::StaticOrder, true, true>(lds, g, S, E); }
                __syncthreads();
#ifndef NO_ATTN
                {
                    unsigned* ctr = (unsigned*)(ws + WS_BAR) + 3840 + 64 * l;
                    volatile LAS unsigned* nxt = (volatile LAS unsigned*)(lds + 151552 + 256);
                    for (;;) {
                        if (tid == 0) *nxt = __hip_atomic_fetch_add(ctr, 1u, __ATOMIC_RELAXED, __HIP_MEMORY_SCOPE_AGENT);
                        __syncthreads();
                        const int u = (int)*nxt;
                        __syncthreads();
                        if (u >= 48 * 16) break;
                        attn_dispatch(a, l, lds, u % 48, 15 - u / 48);
                    }
                }
#endif
            }
        }
        if (ph + 1 < a.ph_hi) {
            if (ph == 0) { cg::this_grid().sync();
#if MK_COOP
                if (mytid() == 0) (void)xb_add(&bar.bar[XB_XCNT(bar.x)], 1u);
#endif
            } else xcd_barrier(bar);
        }
    }
}

extern "C" void kernel_launch(void* const* d_in, const int* in_sizes, int n_in, void* d_out, int out_size, void* d_ws, size_t ws_size, hipStream_t stream) {
    static int grid = 0;
    if (grid == 0) {
        if (n_in != 22 || out_size != M * D || ws_size < WS_END) { fprintf(stderr, "kernel_launch: unexpected shapes (n_in %d out %d ws %zu need %zu)\n", n_in, out_size, ws_size, (size_t)WS_END); grid = -1; return; }
        int dev = 0, cus = 0, per_cu = 0;
        hipGetDevice(&dev); hipDeviceGetAttribute(&cus, hipDeviceAttributeMultiprocessorCount, dev);
        if (hipFuncSetAttribute((const void*)mega_fwd, hipFuncAttributeMaxDynamicSharedMemorySize, LDS_BYTES) != hipSuccess) { fprintf(stderr, "kernel_launch: hipFuncSetAttribute failed\n"); grid = -1; return; }
        if (hipOccupancyMaxActiveBlocksPerMultiprocessor(&per_cu, (const void*)mega_fwd, NTHR, LDS_BYTES) != hipSuccess || per_cu < 1) per_cu = 1;
        (void)hipGetLastError();
        grid = cus * per_cu;
        if (grid > cus) grid = cus;
    }
    if (grid < 0) return;
#if !MK_COOP
    if (hipMemsetAsync((char*)d_ws + WS_BAR, 0, BAR_BYTES, stream) != hipSuccess) { fprintf(stderr, "kernel_launch: memset failed\n"); return; }
#endif
    Args a{};
    for (int i = 0; i < 22; ++i) a.in[i] = (const float*)d_in[i];
    a.out = (float*)d_out; a.ws = (unsigned char*)d_ws;
#if MK_COOP
    a.ph_lo = 0; a.ph_hi = NPHASE;
    void* kargs[] = {&a};
    hipError_t e = hipLaunchCooperativeKernel((const void*)mega_fwd, dim3(grid), dim3(NTHR), kargs, LDS_BYTES, stream);
    if (e != hipSuccess) fprintf(stderr, "cooperative launch failed: %s (grid %d)\n", hipGetErrorString(e), grid);
#else
    for (int ph = 0; ph < NPHASE; ++ph) {
        a.ph_lo = ph; a.ph_hi = ph + 1;
        hipLaunchKernelGGL(mega_fwd, dim3(grid), dim3(NTHR), LDS_BYTES, stream, a);
    }
#endif
}
```
